# Optimizing an MI355X kernel written in HIP

```python
import math
import jax, jax.numpy as jnp
from jax import lax
import numpy as np

D_MODEL = 1024
BATCH = 8
SEQ = 4096
DEPTH = 2

N_MIXERS = 2
N_NSA_LAYERS = (DEPTH + 1) // 2
N_DIFF_LAYERS = DEPTH // 2
EPS = 1e-6
ROPE_THETA = 500000.0
ROT_FRACTION_DIV = 4
D_FF = 4 * D_MODEL
NEG_INF = -1e30
BIG = 1e9

NSA_HEAD_DIM = 64
NSA_HEADS = D_MODEL // NSA_HEAD_DIM
NSA_KV_GROUPS = 4
NSA_HPG = NSA_HEADS // NSA_KV_GROUPS
CMP_BLOCK = 32
CMP_STRIDE = 16
CMP_HIDDEN = 4 * NSA_HEAD_DIM
SLC_BLOCK = 64
SLC_TOPK = 16
WINDOW = 512
NSA_Q_BLOCK = 32
NSA_KV_WIDTH = NSA_KV_GROUPS * NSA_HEAD_DIM
NSA_IN_SPLITS = [NSA_HEADS * NSA_HEAD_DIM] + [NSA_KV_WIDTH] * 6 + [NSA_HEADS * 3]
NSA_IN_WIDTH = sum(NSA_IN_SPLITS)

DIFF_HEAD_DIM = 64
DIFF_HEADS = D_MODEL // (2 * DIFF_HEAD_DIM)
DIFF_IN_WIDTH = 3 * D_MODEL
ATTN_Q_BLOCK = 128

kernel_name = "hybrid_nsa_diffattn_sqrelu"


def rms_norm(x, g):
    xf = x.astype(jnp.float32)
    y = xf * lax.rsqrt(jnp.mean(xf * xf, axis=-1, keepdims=True) + EPS)
    return (y * g.astype(jnp.float32)).astype(x.dtype)


def rope_tables(positions, head_dim):
    rot = head_dim // ROT_FRACTION_DIV
    inv = 1.0 / (ROPE_THETA ** (jnp.arange(0, rot, 2, dtype=jnp.float32) / rot))
    ang = positions.astype(jnp.float32)[:, None] * inv[None, :]
    return jnp.cos(ang), jnp.sin(ang)


def apply_partial_rope(x, cos, sin):
    half = cos.shape[-1]
    x1, x2, xp = x[..., :half], x[..., half:2 * half], x[..., 2 * half:]
    c = cos.astype(x.dtype)
    s = sin.astype(x.dtype)
    return jnp.concatenate([x1 * c - x2 * s, x2 * c + x1 * s, xp], axis=-1)


def masked_softmax(s, mask):
    s = jnp.where(mask, s.astype(jnp.float32), NEG_INF)
    p = jax.nn.softmax(s, axis=-1)
    return jnp.where(mask, p, 0.0)


def compress_blocks(kv, pos_emb, w1, w2):
    S = kv.shape[2]
    nc = (S - CMP_BLOCK) // CMP_STRIDE + 1
    idx = jnp.arange(nc)[:, None] * CMP_STRIDE + jnp.arange(CMP_BLOCK)[None, :]
    blocks = kv[:, :, idx, :] + pos_emb.astype(kv.dtype)
    flat = blocks.reshape(blocks.shape[:3] + (CMP_BLOCK * NSA_HEAD_DIM,))
    return jax.nn.gelu(flat @ w1) @ w2


def nsa_mixer(h, w_in, ck_pos, ck_w1, ck_w2, cv_pos, cv_w1, cv_w2, w_out):
    B, S, _ = h.shape
    G, P, hd = NSA_KV_GROUPS, NSA_HPG, NSA_HEAD_DIM
    proj = h @ w_in
    q, k_cmp, v_cmp, k_slc, v_slc, k_win, v_win, g_log = jnp.split(
        proj, list(np.cumsum(NSA_IN_SPLITS)[:-1]), axis=-1)
    q = q.reshape(B, S, G, P, hd).transpose(0, 2, 3, 1, 4)
    gates = jax.nn.sigmoid(g_log.reshape(B, S, G, P, 3).astype(jnp.float32))
    gates = gates.transpose(0, 2, 3, 1, 4).astype(h.dtype)
    kvg = lambda t: t.reshape(B, S, G, hd).transpose(0, 2, 1, 3)
    k_cmp, v_cmp, k_slc, v_slc, k_win, v_win = map(kvg, (k_cmp, v_cmp, k_slc, v_slc, k_win, v_win))

    pos = jnp.arange(S)
    cos, sin = rope_tables(pos, hd)
    q = apply_partial_rope(q, cos, sin)
    k_slc = apply_partial_rope(k_slc, cos, sin)
    k_win = apply_partial_rope(k_win, cos, sin)

    nc = (S - CMP_BLOCK) // CMP_STRIDE + 1
    cmp_start = jnp.arange(nc) * CMP_STRIDE
    cmp_end = cmp_start + CMP_BLOCK - 1
    kc = compress_blocks(k_cmp, ck_pos, ck_w1, ck_w2)
    vc = compress_blocks(v_cmp, cv_pos, cv_w1, cv_w2)
    ccos, csin = rope_tables(cmp_end, hd)
    kc = apply_partial_rope(kc, ccos, csin)

    n_slc = S // SLC_BLOCK
    topk = min(SLC_TOPK, n_slc)
    sj = jnp.arange(n_slc) * SLC_BLOCK
    sel_map = ((cmp_end[:, None] >= sj[None, :]) &
               (cmp_start[:, None] <= sj[None, :] + SLC_BLOCK - 1)).astype(jnp.float32)
    ks_blocks = k_slc.reshape(B, G, n_slc, SLC_BLOCK, hd)
    vs_blocks = v_slc.reshape(B, G, n_slc, SLC_BLOCK, hd)
    gather = jax.vmap(jax.vmap(lambda blk, ix: blk[ix]))

    k_win_pad = jnp.pad(k_win, ((0, 0), (0, 0), (WINDOW, 0), (0, 0)))
    v_win_pad = jnp.pad(v_win, ((0, 0), (0, 0), (WINDOW, 0), (0, 0)))

    scale = hd ** -0.5
    Cq = NSA_Q_BLOCK
    blk_ids = jnp.arange(n_slc)

    def chunk(c):
        t0 = c * Cq
        tq = t0 + jnp.arange(Cq)
        qc = lax.dynamic_slice_in_dim(q, t0, Cq, axis=3) * jnp.asarray(scale, q.dtype)
        gc = lax.dynamic_slice_in_dim(gates, t0, Cq, axis=3)

        s_c = jnp.einsum('bgpqd,bgnd->bgpqn', qc, kc)
        p_c = masked_softmax(s_c, cmp_end[None, :] <= tq[:, None])
        o_c = jnp.einsum('bgpqn,bgnd->bgpqd', p_c.astype(vc.dtype), vc)

        imp = jnp.einsum('bgpqn,nj->bgqj', p_c, sel_map)
        cur = (tq // SLC_BLOCK)[:, None]
        forced = (blk_ids[None, :] == 0) | (blk_ids[None, :] == cur) | (blk_ids[None, :] == cur - 1)
        future = blk_ids[None, :] * SLC_BLOCK > tq[:, None]
        imp = jnp.where(forced, BIG, jnp.where(future, -BIG, imp))
        _, sel = lax.top_k(imp, topk)
        ks = gather(ks_blocks, sel)
        vs = gather(vs_blocks, sel)
        tok = sel[..., None] * SLC_BLOCK + jnp.arange(SLC_BLOCK)
        m_s = (tok <= tq[None, None, :, None, None]).reshape(B, G, 1, Cq, topk * SLC_BLOCK)
        s_s = jnp.einsum('bgpqd,bgqkld->bgpqkl', qc, ks).reshape(B, G, P, Cq, topk * SLC_BLOCK)
        p_s = masked_softmax(s_s, m_s).reshape(B, G, P, Cq, topk, SLC_BLOCK)
        o_s = jnp.einsum('bgpqkl,bgqkld->bgpqd', p_s.astype(vs.dtype), vs)

        kw = lax.dynamic_slice_in_dim(k_win_pad, t0, WINDOW + Cq, axis=2)
        vw = lax.dynamic_slice_in_dim(v_win_pad, t0, WINDOW + Cq, axis=2)
        pw = t0 - WINDOW + jnp.arange(WINDOW + Cq)
        m_w = (pw[None, :] <= tq[:, None]) & (pw[None, :] > tq[:, None] - WINDOW) & (pw[None, :] >= 0)
        s_w = jnp.einsum('bgpqd,bgkd->bgpqk', qc, kw)
        p_w = masked_softmax(s_w, m_w)
        o_w = jnp.einsum('bgpqk,bgkd->bgpqd', p_w.astype(vw.dtype), vw)

        return gc[..., 0:1] * o_c + gc[..., 1:2] * o_s + gc[..., 2:3] * o_w

    out = lax.map(chunk, jnp.arange(S // Cq))
    out = out.transpose(1, 0, 4, 2, 3, 5).reshape(B, S, NSA_HEADS * hd)
    return out @ w_out


def diff_mixer(h, w_in, lq1, lk1, lq2, lk2, subln_g, w_out, lambda_init):
    B, S, _ = h.shape
    H, hd = DIFF_HEADS, DIFF_HEAD_DIM
    q, k, v = jnp.split(h @ w_in, 3, axis=-1)
    q = q.reshape(B, S, H, 2, hd).transpose(0, 2, 3, 1, 4)
    k = k.reshape(B, S, H, 2, hd).transpose(0, 2, 3, 1, 4)
    v = v.reshape(B, S, H, 2 * hd).transpose(0, 2, 1, 3)
    cos, sin = rope_tables(jnp.arange(S), hd)
    q = apply_partial_rope(q, cos, sin) * jnp.asarray(hd ** -0.5, q.dtype)
    k = apply_partial_rope(k, cos, sin)
    f32 = jnp.float32
    lam = (jnp.exp(jnp.sum(lq1.astype(f32) * lk1.astype(f32))) -
           jnp.exp(jnp.sum(lq2.astype(f32) * lk2.astype(f32))) + lambda_init)
    kpos = jnp.arange(S)
    Qb = ATTN_Q_BLOCK

    def block(c):
        t0 = c * Qb
        tq = t0 + jnp.arange(Qb)
        qc = lax.dynamic_slice_in_dim(q, t0, Qb, axis=3)
        s = jnp.einsum('bhiqd,bhikd->bhiqk', qc, k)
        p = masked_softmax(s, kpos[None, :] <= tq[:, None])
        a = p[:, :, 0] - lam * p[:, :, 1]
        o = jnp.einsum('bhqk,bhkd->bhqd', a.astype(v.dtype), v)
        return rms_norm(o, subln_g) * jnp.asarray(1.0 - lambda_init, o.dtype)

    out = lax.map(block, jnp.arange(S // Qb))
    out = out.transpose(1, 0, 3, 2, 4).reshape(B, S, H * 2 * hd)
    return out @ w_out


def sqrelu_mlp(h, w_up, w_down):
    u = jax.nn.relu(h @ w_up)
    return (u * u) @ w_down


def setup_inputs(seed: int = 0) -> dict:
    key = jax.random.key(seed)
    ks = list(jax.random.split(key, 24))
    nrm = lambda k, shape, s: jax.random.normal(k, shape, jnp.float32) * s
    LA, LB, hd = N_NSA_LAYERS, N_DIFF_LAYERS, NSA_HEAD_DIM
    return {
        "x": nrm(ks[0], (BATCH, SEQ, D_MODEL), 1.0),
        "attn_norm_g": 1.0 + nrm(ks[1], (DEPTH, D_MODEL), 0.02),
        "mlp_norm_g": 1.0 + nrm(ks[2], (DEPTH, D_MODEL), 0.02),
        "nsa_w_in": nrm(ks[3], (LA, D_MODEL, NSA_IN_WIDTH), D_MODEL ** -0.5),
        "nsa_ck_pos": nrm(ks[4], (LA, CMP_BLOCK, hd), 0.1),
        "nsa_ck_w1": nrm(ks[5], (LA, CMP_BLOCK * hd, CMP_HIDDEN), (CMP_BLOCK * hd) ** -0.5),
        "nsa_ck_w2": nrm(ks[6], (LA, CMP_HIDDEN, hd), CMP_HIDDEN ** -0.5),
        "nsa_cv_pos": nrm(ks[7], (LA, CMP_BLOCK, hd), 0.1),
        "nsa_cv_w1": nrm(ks[8], (LA, CMP_BLOCK * hd, CMP_HIDDEN), (CMP_BLOCK * hd) ** -0.5),
        "nsa_cv_w2": nrm(ks[9], (LA, CMP_HIDDEN, hd), CMP_HIDDEN ** -0.5),
        "nsa_w_out": nrm(ks[10], (LA, D_MODEL, D_MODEL), D_MODEL ** -0.5),
        "diff_w_in": nrm(ks[11], (LB, D_MODEL, DIFF_IN_WIDTH), D_MODEL ** -0.5),
        "diff_lq1": nrm(ks[12], (LB, DIFF_HEAD_DIM), 0.1),
        "diff_lk1": nrm(ks[13], (LB, DIFF_HEAD_DIM), 0.1),
        "diff_lq2": nrm(ks[14], (LB, DIFF_HEAD_DIM), 0.1),
        "diff_lk2": nrm(ks[15], (LB, DIFF_HEAD_DIM), 0.1),
        "diff_subln_g": 1.0 + nrm(ks[16], (LB, 2 * DIFF_HEAD_DIM), 0.02),
        "diff_w_out": nrm(ks[17], (LB, D_MODEL, D_MODEL), D_MODEL ** -0.5),
        "mlp_w_up": nrm(ks[18], (DEPTH, D_MODEL, D_FF), D_MODEL ** -0.5),
        "mlp_w_down": nrm(ks[19], (DEPTH, D_FF, D_MODEL), D_FF ** -0.5),
        "final_norm_g": 1.0 + nrm(ks[20], (D_MODEL,), 0.02),
    }


def reference(x, attn_norm_g, mlp_norm_g, nsa_w_in, nsa_ck_pos, nsa_ck_w1, nsa_ck_w2,
              nsa_cv_pos, nsa_cv_w1, nsa_cv_w2, nsa_w_out, diff_w_in, diff_lq1, diff_lk1,
              diff_lq2, diff_lk2, diff_subln_g, diff_w_out, mlp_w_up, mlp_w_down, final_norm_g):
    for i in range(DEPTH):
        h = rms_norm(x, attn_norm_g[i])
        j = i // N_MIXERS
        if i % N_MIXERS == 0:
            mix = nsa_mixer(h, nsa_w_in[j], nsa_ck_pos[j], nsa_ck_w1[j], nsa_ck_w2[j],
                            nsa_cv_pos[j], nsa_cv_w1[j], nsa_cv_w2[j], nsa_w_out[j])
        else:
            lambda_init = 0.8 - 0.6 * math.exp(-0.3 * i)
            mix = diff_mixer(h, diff_w_in[j], diff_lq1[j], diff_lk1[j], diff_lq2[j], diff_lk2[j],
                             diff_subln_g[j], diff_w_out[j], lambda_init)
        x = x + mix
        x = x + sqrelu_mlp(rms_norm(x, mlp_norm_g[i]), mlp_w_up[i], mlp_w_down[i])
    return rms_norm(x, final_norm_g)
```

```cpp
#include <hip/hip_runtime.h>
#include <hip/hip_cooperative_groups.h>
#include <stdint.h>
#include <cstdio>
namespace cg = cooperative_groups;

typedef unsigned short bf16_t;
typedef short bf16x8 __attribute__((ext_vector_type(8)));
typedef float f32x4 __attribute__((ext_vector_type(4)));
typedef unsigned u32x4 __attribute__((ext_vector_type(4)));
typedef unsigned u32x2 __attribute__((ext_vector_type(2)));
typedef unsigned long long u64;

constexpr int NB = 8, S = 4096, D = 1024, T = NB * S, FF = 4096;
constexpr int LDA = 2176;
constexpr float EPS = 1e-6f;
constexpr float LAMBDA_INIT = 0.35550906759096934f;
constexpr int SMEM_BYTES = 73728;

constexpr size_t MiB = 1048576;
constexpr size_t OFF_WT = 0, OFF_ROPE = 52 * MiB, OFF_KC = 53 * MiB, OFF_VCT = 54 * MiB, OFF_XN = 56 * MiB,
                 OFF_PROJA = 120 * MiB, OFF_PROJVT = 256 * MiB, OFF_ATTN = 320 * MiB, OFF_HID = 120 * MiB, WS_NEED = 384 * MiB;
constexpr size_t WT_NSA_IN = 0, WT_NSA_OUT = 2752512, WT_DIFF_IN = 3801088, WT_DIFF_OUT = 6946816, WT_UP0 = 7995392, WT_UP1 = 12189696,
                 WT_DN0 = 16384000, WT_DN1 = 20578304, WT_CKW1 = 24772608, WT_CVW1 = 25296896, WT_CKW2 = 25821184, WT_CVW2 = 25837568;

struct Params {
    const float* in[21];
    float* out;
    char* ws;
};

typedef __bf16 bf16x2_t __attribute__((ext_vector_type(2)));
typedef float f32x2_t __attribute__((ext_vector_type(2)));
__device__ __forceinline__ unsigned cvt_pk_bf16(float lo, float hi) { const f32x2_t f = {lo, hi}; return __builtin_bit_cast(unsigned, __builtin_convertvector(f, bf16x2_t)); }
__device__ __forceinline__ float bf_lo(unsigned u) { return __uint_as_float(u << 16); }
__device__ __forceinline__ float bf_hi(unsigned u) { return __uint_as_float(u & 0xffff0000u); }
__device__ __forceinline__ u32x2 pack4(f32x4 v) { u32x2 r; r.x = cvt_pk_bf16(v[0], v[1]); r.y = cvt_pk_bf16(v[2], v[3]); return r; }
__device__ __forceinline__ f32x4 mfma16(bf16x8 a, bf16x8 b, f32x4 c) { return __builtin_amdgcn_mfma_f32_16x16x32_bf16(a, b, c, 0, 0, 0); }
__device__ __forceinline__ f32x4 zero4() { return (f32x4){0.f, 0.f, 0.f, 0.f}; }

__device__ __forceinline__ int lds_byte(int r, int c) {
    const int st = (r >> 4) * 2 + (c >> 5), ob = (r & 15) * 64 + (c & 31) * 2;
    return st * 1024 + (ob ^ (((ob >> 9) & 1) << 5));
}
__device__ __forceinline__ void stage_rc(int b, int& R, int& C) {
    const int st = b >> 10, sb = b & 1023, swz = sb ^ (((sb >> 9) & 1) << 5);
    R = (st >> 1) * 16 + swz / 64;
    C = (st & 1) * 32 + (swz % 64) / 2;
}
constexpr int TILE_B = 128 * 64 * 2;
template <class Epi>
__device__ __forceinline__ void gemm_tile(const bf16_t* __restrict__ A, const bf16_t* __restrict__ Bt, int K, int row0, int col0, const Epi& epi, char* smem,
                                          bool prefetched, bool nvalid, int nrow0, int ncol0) {
    const int tid = threadIdx.x, lane = tid & 63, w = tid >> 6, wr = w >> 1, wc = w & 1, fr = lane & 15, fq = lane >> 4;
    f32x4 acc[4][4];
#pragma unroll
    for (int m = 0; m < 4; ++m)
#pragma unroll
        for (int n = 0; n < 4; ++n) acc[m][n] = zero4();
    int soffA[4], soffB[4];
#pragma unroll
    for (int i = 0; i < 4; ++i) {
        const int row = (w + 4 * i) * 8 + (lane >> 3), cp = lane & 7;
        soffA[i] = row * K + (cp ^ ((row >> 1) & 7)) * 8;
        soffB[i] = row * K + (cp ^ (((row >> 1) & 1) | (((row >> 3) & 1) << 1) | (((row >> 4) & 1) << 2))) * 8;
    }
    const bf16_t* pA = A + (size_t)row0 * K;
    const bf16_t* pB = Bt + (size_t)col0 * K;
#define GLDS_STAGE(buf, PA, PB, kt) do { _Pragma("unroll") for (int i = 0; i < 4; ++i) { \
        __builtin_amdgcn_global_load_lds((const unsigned*)((PA) + soffA[i] + (kt) * 64), (__attribute__((address_space(3))) unsigned*)(smem + (buf) * 2 * TILE_B + w * 1024 + i * 4096), 16, 0, 0); \
        __builtin_amdgcn_global_load_lds((const unsigned*)((PB) + soffB[i] + (kt) * 64), (__attribute__((address_space(3))) unsigned*)(smem + (buf) * 2 * TILE_B + TILE_B + w * 1024 + i * 4096), 16, 0, 0); } } while (0)
    int offA[4][2], offB[4][2];
#pragma unroll
    for (int m = 0; m < 4; ++m)
#pragma unroll
        for (int ks = 0; ks < 2; ++ks) { const int cx = ((ks * 4 + fq) ^ ((fr >> 1) & 7)) * 16;
            offA[m][ks] = (wr * 64 + m * 16 + fr) * 128 + cx;
            offB[m][ks] = TILE_B + (wc * 64 + (m >> 1) * 32 + 8 * (fr >> 2) + 4 * (m & 1) + (fr & 3)) * 128 + cx; }
    if (prefetched) {
        if (Epi::STAGED) asm volatile("s_waitcnt vmcnt(8)" ::: "memory");
        else asm volatile("s_waitcnt vmcnt(0)" ::: "memory");
    } else {
        GLDS_STAGE(0, pA, pB, 0);
        asm volatile("s_waitcnt vmcnt(0)" ::: "memory");
    }
    __syncthreads();
    const int nk = K >> 6;
    for (int kt = 0; kt < nk; ++kt) {
        const int cur = kt & 1;
        if (kt + 1 < nk) GLDS_STAGE(cur ^ 1, pA, pB, kt + 1);
        const char* cb = smem + cur * 2 * TILE_B;
#pragma unroll
        for (int ks = 0; ks < 2; ++ks) {
            bf16x8 a[4], b[4];
#pragma unroll
            for (int m = 0; m < 4; ++m) a[m] = *(const bf16x8*)(cb + offA[m][ks]);
#pragma unroll
            for (int n = 0; n < 4; ++n) b[n] = *(const bf16x8*)(cb + offB[n][ks]);
#pragma unroll
            for (int m = 0; m < 4; ++m)
#pragma unroll
                for (int n = 0; n < 4; ++n) acc[m][n] = mfma16(b[n], a[m], acc[m][n]);
        }
        asm volatile("s_waitcnt vmcnt(0)" ::: "memory");
        __syncthreads();
    }
    if (nvalid) { const bf16_t* qA = A + (size_t)nrow0 * K; const bf16_t* qB = Bt + (size_t)ncol0 * K; GLDS_STAGE(0, qA, qB, 0); }
#undef GLDS_STAGE
    if constexpr (Epi::STAGED) {
        bf16_t* st = (bf16_t*)(smem + 2 * TILE_B);
        epi.to_lds(acc, st, row0, col0, wr, wc, fr, fq);
        __syncthreads();
        bf16_t* gbase; size_t gstride;
        epi.dest(row0, col0, gbase, gstride);
        const int r0 = tid >> 4, ch = (tid & 15) * 8;
#pragma unroll
        for (int it = 0; it < 8; ++it) { const int r = it * 16 + r0; __builtin_nontemporal_store(*(const u32x4*)(st + r * 136 + ch), (u32x4*)(gbase + (size_t)r * gstride + ch)); }
    } else {
        epi(acc, row0 + wr * 64, col0 + wc * 64, fr, fq);
    }
    if (!nvalid) { asm volatile("s_waitcnt vmcnt(0) lgkmcnt(0)" ::: "memory"); __syncthreads(); }
}

__device__ __forceinline__ u32x4 pack8(f32x4 a, f32x4 b) { u32x4 r; r.x = cvt_pk_bf16(a[0], a[1]); r.y = cvt_pk_bf16(a[2], a[3]); r.z = cvt_pk_bf16(b[0], b[1]); r.w = cvt_pk_bf16(b[2], b[3]); return r; }
struct EpiProj {
    static constexpr bool STAGED = true;
    bf16_t* out; int ld; int rope_lo2; const float* rope;
    __device__ __forceinline__ void dest(int row0, int col0, bf16_t*& g, size_t& stride) const { g = out + (size_t)row0 * ld + col0; stride = (size_t)ld; }
    __device__ __forceinline__ void to_lds(f32x4 (&acc)[4][4], bf16_t* st, int row0, int col0, int wr, int wc, int fr, int fq) const {
        const int cb = col0 + wc * 64;
        const bool isq = cb < 1024;
        const bool dorope = (cb < 1024) || (cb >= rope_lo2 && cb < 2048);
#pragma unroll
        for (int m = 0; m < 4; ++m) {
            const int rl = wr * 64 + m * 16 + fr;
            const int s = (row0 + rl) & (S - 1);
#pragma unroll
            for (int pp = 0; pp < 2; ++pp) {
                f32x4 v0 = acc[m][2 * pp], v1 = acc[m][2 * pp + 1];
                if (pp == 0 && dorope) {
                    f32x4 p0, p1;
#pragma unroll
                    for (int j = 0; j < 4; ++j) { p0[j] = __shfl_xor(v0[j], 16); p1[j] = __shfl_xor(v1[j], 16); }
                    const float* rp = rope + s * 16;
                    const f32x4 c0 = *(const f32x4*)rp, c1 = *(const f32x4*)(rp + 4), s0 = *(const f32x4*)(rp + 8), s1 = *(const f32x4*)(rp + 12);
                    if (fq == 0) { v0 = v0 * c0 - p0 * s0; v1 = v1 * c1 - p1 * s1; }
                    else if (fq == 1) { v0 = v0 * c0 + p0 * s0; v1 = v1 * c1 + p1 * s1; }
                }
                if (isq) { v0 = v0 * 0.18033688011112042f; v1 = v1 * 0.18033688011112042f; }
                *(u32x4*)(st + rl * 136 + wc * 64 + pp * 32 + 8 * fq) = pack8(v0, v1);
            }
        }
    }
};
struct EpiVT {
    static constexpr bool STAGED = true;
    bf16_t* out; int MV;
    __device__ __forceinline__ void dest(int row0, int col0, bf16_t*& g, size_t& stride) const { g = out + ((size_t)(col0 >> 12) * MV + row0) * S + (col0 & (S - 1)); stride = (size_t)S; }
    __device__ __forceinline__ void to_lds(f32x4 (&acc)[4][4], bf16_t* st, int row0, int col0, int wr, int wc, int fr, int fq) const {
#pragma unroll
        for (int m = 0; m < 4; ++m)
#pragma unroll
            for (int pp = 0; pp < 2; ++pp)
                *(u32x4*)(st + (wr * 64 + m * 16 + fr) * 136 + wc * 64 + pp * 32 + 8 * fq) = pack8(acc[m][2 * pp], acc[m][2 * pp + 1]);
    }
};
struct EpiResid {
    static constexpr bool STAGED = false;
    const float* res; float* out;
    __device__ __forceinline__ void operator()(f32x4 (&acc)[4][4], int rb, int cb, int fr, int fq) const {
        f32x4 r[4][2][2];
#pragma unroll
        for (int m = 0; m < 4; ++m)
#pragma unroll
            for (int pp = 0; pp < 2; ++pp) {
                const size_t o = (size_t)(rb + m * 16 + fr) * D + cb + pp * 32 + 8 * fq;
                r[m][pp][0] = __builtin_nontemporal_load((const f32x4*)(res + o));
                r[m][pp][1] = __builtin_nontemporal_load((const f32x4*)(res + o + 4));
            }
#pragma unroll
        for (int m = 0; m < 4; ++m)
#pragma unroll
            for (int pp = 0; pp < 2; ++pp) {
                const size_t o = (size_t)(rb + m * 16 + fr) * D + cb + pp * 32 + 8 * fq;
                *(f32x4*)(out + o) = r[m][pp][0] + acc[m][2 * pp];
                *(f32x4*)(out + o + 4) = r[m][pp][1] + acc[m][2 * pp + 1];
            }
    }
};
struct EpiSqRelu {
    static constexpr bool STAGED = true;
    bf16_t* out;
    __device__ __forceinline__ void dest(int row0, int col0, bf16_t*& g, size_t& stride) const { g = out + (size_t)row0 * FF + col0; stride = (size_t)FF; }
    __device__ __forceinline__ void to_lds(f32x4 (&acc)[4][4], bf16_t* st, int row0, int col0, int wr, int wc, int fr, int fq) const {
#pragma unroll
        for (int m = 0; m < 4; ++m)
#pragma unroll
            for (int pp = 0; pp < 2; ++pp) {
                f32x4 v0 = acc[m][2 * pp], v1 = acc[m][2 * pp + 1];
#pragma unroll
                for (int j = 0; j < 4; ++j) { const float u0 = fmaxf(v0[j], 0.f), u1 = fmaxf(v1[j], 0.f); v0[j] = u0 * u0; v1[j] = u1 * u1; }
                *(u32x4*)(st + (wr * 64 + m * 16 + fr) * 136 + wc * 64 + pp * 32 + 8 * fq) = pack8(v0, v1);
            }
    }
};

template <class Epi>
__device__ __forceinline__ void gemm_phase(const bf16_t* A, const bf16_t* Bt, int M, int N, int K, const Epi& epi, char* smem) {
    const int nN = N >> 7, ntiles = (M >> 7) * nN, G = gridDim.x;
    bool pre = false;
    for (int i = blockIdx.x; i < ntiles; i += G) {
        const int j = i + G; const bool nv = j < ntiles;
        gemm_tile(A, Bt, K, (i / nN) << 7, (i % nN) << 7, epi, smem, pre, nv, (j / nN) << 7, (j % nN) << 7);
        pre = nv;
    }
}
template <class E1, class E2>
__device__ __forceinline__ void gemm_phase2(const bf16_t* A1, const bf16_t* B1, int M1, int N1, const E1& e1,
                                            const bf16_t* A2, const bf16_t* B2, int M2, int N2, const E2& e2, int K, char* smem) {
    gemm_phase(A1, B1, M1, N1, K, e1, smem);
    const int nM2 = M2 >> 7, nt2 = nM2 * (N2 >> 7), G = gridDim.x;
    bool pre = false;
    for (int i = (blockIdx.x + (G >> 1)) % G; i < nt2; i += G) {
        const int j = i + G; const bool nv = j < nt2;
        gemm_tile(A2, B2, K, (i % nM2) << 7, (i / nM2) << 7, e2, smem, pre, nv, (j % nM2) << 7, (j / nM2) << 7);
        pre = nv;
    }
}

__device__ __forceinline__ void rmsnorm_phase(const float* x, const float* g, bf16_t* outb, float* outf) {
    const int lane = threadIdx.x & 63;
    const int gw = blockIdx.x * 4 + (threadIdx.x >> 6), nw = gridDim.x * 4;
    f32x4 gv[4];
#pragma unroll
    for (int i = 0; i < 4; ++i) gv[i] = *(const f32x4*)(g + (lane + i * 64) * 4);
    for (int row = gw; row < T; row += nw) {
        const float* xr = x + (size_t)row * D;
        f32x4 v[4];
        float ss = 0.f;
#pragma unroll
        for (int i = 0; i < 4; ++i) { v[i] = __builtin_nontemporal_load((const f32x4*)(xr + (lane + i * 64) * 4)); ss += v[i][0] * v[i][0] + v[i][1] * v[i][1] + v[i][2] * v[i][2] + v[i][3] * v[i][3]; }
#pragma unroll
        for (int o = 32; o >= 1; o >>= 1) ss += __shfl_xor(ss, o);
        const float r = rsqrtf(ss * (1.0f / D) + EPS);
#pragma unroll
        for (int i = 0; i < 4; ++i) {
            const f32x4 y = v[i] * r * gv[i];
            if (outb) *(u32x2*)(outb + (size_t)row * D + (lane + i * 64) * 4) = pack4(y);
            else __builtin_nontemporal_store(y, (f32x4*)(outf + (size_t)row * D + (lane + i * 64) * 4));
        }
    }
}

__device__ __forceinline__ int nsa_in_rowmap(int n) {
    if (n < 1792) return n;
    if (n < 2048) return 2176 + (n - 1792);
    if (n < 2304) return 1792 + (n - 2048);
    if (n < 2560) return 2176 + 256 + (n - 2304);
    return 2048 + (n - 2560);
}
__device__ __forceinline__ void tr_tile(const float* __restrict__ src, int K, int N, bf16_t* __restrict__ dst, bool remap, int kt, int nt, float* sm) {
    const int tid = threadIdx.x;
    const int r = tid >> 4, c4 = (tid & 15) * 4;
#pragma unroll
    for (int i = 0; i < 4; ++i) {
        const int k = kt * 64 + r + i * 16, n = nt * 64 + c4;
        f32x4 v = zero4();
        if (n < N) v = __builtin_nontemporal_load((const f32x4*)(src + (size_t)k * N + n));
        float* d = sm + (r + i * 16) * 65 + c4;
        d[0] = v[0]; d[1] = v[1]; d[2] = v[2]; d[3] = v[3];
    }
    __syncthreads();
    const int nl = tid >> 2, kc = (tid & 3) * 16, n = nt * 64 + nl;
    if (n < N) {
        const int rr = remap ? nsa_in_rowmap(n) : n;
        unsigned pk[8];
#pragma unroll
        for (int i = 0; i < 8; ++i) pk[i] = cvt_pk_bf16(sm[(kc + 2 * i) * 65 + nl], sm[(kc + 2 * i + 1) * 65 + nl]);
        bf16_t* dp = dst + (size_t)rr * K + kt * 64 + kc;
        *(u32x4*)dp = (u32x4){pk[0], pk[1], pk[2], pk[3]};
        *(u32x4*)(dp + 8) = (u32x4){pk[4], pk[5], pk[6], pk[7]};
    }
    __syncthreads();
}
__device__ __forceinline__ void prologue_phase(const Params& p, char* smem) {
    bf16_t* WT = (bf16_t*)(p.ws + OFF_WT);
    float* sm = (float*)smem;
    constexpr int NJ = 12;
    constexpr int NTR = 656 + 256 + 768 + 256 + 4096 + 256 + 8;
    const int ntask = NTR + 16;
    for (int task = blockIdx.x; task < ntask; task += gridDim.x) {
        if (task < NTR) {
            int t = task; const float* src; int K, N; bf16_t* dst; bool remap = false;
            if (t < 656) { src = p.in[3]; K = 1024; N = 2608; dst = WT + WT_NSA_IN; remap = true; }
            else if ((t -= 656) < 256) { src = p.in[10]; K = 1024; N = 1024; dst = WT + WT_NSA_OUT; }
            else if ((t -= 256) < 768) { src = p.in[11]; K = 1024; N = 3072; dst = WT + WT_DIFF_IN; }
            else if ((t -= 768) < 256) { src = p.in[17]; K = 1024; N = 1024; dst = WT + WT_DIFF_OUT; }
            else if ((t -= 256) < 1024) { src = p.in[18]; K = 1024; N = 4096; dst = WT + WT_UP0; }
            else if ((t -= 1024) < 1024) { src = p.in[18] + (size_t)1024 * 4096; K = 1024; N = 4096; dst = WT + WT_UP1; }
            else if ((t -= 1024) < 1024) { src = p.in[19]; K = 4096; N = 1024; dst = WT + WT_DN0; }
            else if ((t -= 1024) < 1024) { src = p.in[19] + (size_t)4096 * 1024; K = 4096; N = 1024; dst = WT + WT_DN1; }
            else if ((t -= 1024) < 128) { src = p.in[5]; K = 2048; N = 256; dst = WT + WT_CKW1; }
            else if ((t -= 128) < 128) { src = p.in[8]; K = 2048; N = 256; dst = WT + WT_CVW1; }
            else if ((t -= 128) < 4) { src = p.in[6]; K = 256; N = 64; dst = WT + WT_CKW2; }
            else { t -= 4; src = p.in[9]; K = 256; N = 64; dst = WT + WT_CVW2; }
            const int nkt = K >> 6;
            tr_tile(src, K, N, dst, remap, t % nkt, t / nkt, sm);
        } else {
            const int mt = task - NTR;
            float* rope = (float*)(p.ws + OFF_ROPE);
            const float invf[8] = {1.0f, 0.193922758102417f, 0.03760603070259094f, 0.00729266507551074f, 0.001414213445968926f,
                                   0.00027424818836152554f, 5.318296462064609e-05f, 1.0313385246263351e-05f};
            const int pos = mt * 256 + threadIdx.x;
#pragma unroll
            for (int i = 0; i < 8; ++i) {
                const float a = (float)pos * invf[i];
                const double ad = (double)a;
                const double kq = rint(ad * 0.15915494309189535);
                const float rr = (float)(ad - kq * 6.283185307179586);
                rope[pos * 16 + i] = __cosf(rr);
                rope[pos * 16 + 8 + i] = __sinf(rr);
            }
            u32x4* z = (u32x4*)(WT + WT_NSA_IN + (size_t)2096 * 1024);
            for (int i = mt * 256 + threadIdx.x; i < 10240; i += 16 * 256) z[i] = (u32x4){0u, 0u, 0u, 0u};
        }
    }
    (void)NJ;
}

__device__ __forceinline__ float gelu_tanh(float x) {
    const float u = 0.7978845608028654f * (x + 0.044715f * x * x * x);
    const float e = __expf(2.0f * u);
    const float th = 1.0f - 2.0f * __builtin_amdgcn_rcpf(e + 1.0f);
    return 0.5f * x * (1.0f + th);
}
__device__ __forceinline__ void compress_task(const Params& p, int task, char* smem) {
    const int tid = threadIdx.x, lane = tid & 63, w = tid >> 6, fr = lane & 15, fq = lane >> 4;
    const int kv = task >> 9, bg = (task >> 4) & 31, n0 = (task & 15) * 16;
    const int b = bg >> 2, g = bg & 3;
    const bf16_t* WT = (const bf16_t*)(p.ws + OFF_WT);
    const bf16_t* src = (const bf16_t*)(p.ws + OFF_PROJA) + (size_t)b * S * LDA + 1024 + kv * 256 + g * 64;
    const float* pos = kv ? p.in[7] : p.in[4];
    const bf16_t* w1t = WT + (kv ? WT_CVW1 : WT_CKW1);
    const bf16_t* w2t = WT + (kv ? WT_CVW2 : WT_CKW2);
    f32x4 acc[16];
#pragma unroll
    for (int i = 0; i < 16; ++i) acc[i] = zero4();
    const int n = n0 + fr;
#pragma unroll 2
    for (int kq = 0; kq < 16; ++kq) {
        const int kk = w * 16 + kq, l = kk >> 1, d = (kk & 1) * 32 + fq * 8;
        int tok = 16 * n + l; tok = tok < S ? tok : S - 1;
        const u32x4 raw = *(const u32x4*)(src + (size_t)tok * LDA + d);
        const float* pp = pos + l * 64 + d;
        const f32x4 p0 = *(const f32x4*)pp, p1 = *(const f32x4*)(pp + 4);
        u32x4 ap;
        ap.x = cvt_pk_bf16(bf_lo(raw.x) + p0[0], bf_hi(raw.x) + p0[1]);
        ap.y = cvt_pk_bf16(bf_lo(raw.y) + p0[2], bf_hi(raw.y) + p0[3]);
        ap.z = cvt_pk_bf16(bf_lo(raw.z) + p1[0], bf_hi(raw.z) + p1[1]);
        ap.w = cvt_pk_bf16(bf_lo(raw.w) + p1[2], bf_hi(raw.w) + p1[3]);
        const bf16x8 a = __builtin_bit_cast(bf16x8, ap);
#pragma unroll
        for (int nt = 0; nt < 16; ++nt) {
            const bf16x8 bw = *(const bf16x8*)(w1t + (size_t)(nt * 16 + fr) * 2048 + kk * 32 + fq * 8);
            acc[nt] = mfma16(bw, a, acc[nt]);
        }
    }
    float* red = (float*)smem;
    bf16_t* hid = (bf16_t*)(smem + 49920);
    if (w > 0) {
#pragma unroll
        for (int nt = 0; nt < 16; ++nt) *(f32x4*)(red + ((w - 1) * 16 + fr) * 260 + nt * 16 + fq * 4) = acc[nt];
    }
    __syncthreads();
    if (w == 0) {
#pragma unroll
        for (int nt = 0; nt < 16; ++nt) {
            f32x4 v = acc[nt];
#pragma unroll
            for (int ww = 0; ww < 3; ++ww) v = v + *(const f32x4*)(red + (ww * 16 + fr) * 260 + nt * 16 + fq * 4);
#pragma unroll
            for (int j = 0; j < 4; ++j) v[j] = gelu_tanh(v[j]);
            *(u32x2*)(hid + fr * 264 + nt * 16 + fq * 4) = pack4(v);
        }
    }
    __syncthreads();
    f32x4 o = zero4();
#pragma unroll
    for (int kk = 0; kk < 8; ++kk) {
        const bf16x8 hf = *(const bf16x8*)(hid + fr * 264 + kk * 32 + fq * 8);
        const bf16x8 wf = *(const bf16x8*)(w2t + (size_t)(w * 16 + fr) * 256 + kk * 32 + fq * 8);
        if (kv == 0) o = mfma16(wf, hf, o);
        else o = mfma16(hf, wf, o);
    }
    if (kv == 0) {
        bf16_t* kc = (bf16_t*)(p.ws + OFF_KC);
        if (w == 0) {
            const float* rope = (const float*)(p.ws + OFF_ROPE);
            int ps = 16 * n + 31; ps = ps < S ? ps : S - 1;
            f32x4 pv;
#pragma unroll
            for (int j = 0; j < 4; ++j) pv[j] = __shfl_xor(o[j], 32);
            const float* rp = rope + ps * 16 + (fq & 1) * 4;
            const f32x4 c = *(const f32x4*)rp, sn = *(const f32x4*)(rp + 8);
            if (fq < 2) o = o * c - pv * sn; else o = o * c + pv * sn;
        }
        if (n >= 255) o = zero4();
        *(u32x2*)(kc + ((size_t)bg * 256 + n) * 64 + w * 16 + fq * 4) = pack4(o);
    } else {
        bf16_t* vct = (bf16_t*)(p.ws + OFF_VCT);
#pragma unroll
        for (int j = 0; j < 4; ++j) if (n0 + fq * 4 + j >= 255) o[j] = 0.f;
        *(u32x2*)(vct + (((size_t)bg * 16 + (n0 >> 4)) * 64 + w * 16 + fr) * 16 + fq * 4) = pack4(o);
    }
    __syncthreads();
}

template <int KW, int VD, bool SEL>
__device__ __forceinline__ void flash_branch(u64 tiles, const bf16_t* __restrict__ gK, int ldk, const bf16_t* __restrict__ gVT, int kcol,
                                             const bf16x8 (&qf)[2][2], f32x4 (&O)[2][VD / 16], float (&mrow)[2], float (&lrow)[2],
                                             const int (&tpos)[2], const u64 (&selm)[2], const int (&lo)[2], int tmin, int lomax, char* smem) {
    constexpr int KROWB = KW * 2, KB = 64 * KROWB, VB = VD * 128, BUFB = KB + VB;
    constexpr int NKI = KB / 4096, NVI = VB / 4096, KRPI = 1024 / KROWB, KCPR = KROWB / 16;
    int tid = threadIdx.x; asm volatile("" : "+v"(tid));
    const int lane = tid & 63, w = tid >> 6, fr = lane & 15, fq = lane >> 4;
    if (!tiles) return;
    int koff[NKI], voff[NVI];
#pragma unroll
    for (int i = 0; i < NKI; ++i) {
        const int row = (w + 4 * i) * KRPI + lane / KCPR, cp = lane % KCPR;
        const int f = (KW == 64) ? (((row >> 1) & 1) | (((row >> 3) & 1) << 1) | (((row >> 4) & 1) << 2)) : ((row & 3) | (((row >> 3) & 3) << 2));
        koff[i] = row * ldk + (cp ^ f) * 8;
    }
#pragma unroll
    for (int i = 0; i < NVI; ++i) {
        const int row = (w + 4 * i) * 8 + (lane >> 3), cp = lane & 7;
        voff[i] = row * S + (cp ^ ((row >> 1) & 7)) * 8;
    }
#define FL_ISSUE(buf, jt) do { char* sb_ = smem + (buf) * BUFB + w * 1024; const bf16_t* gk_ = gK + (size_t)(jt) * 64 * ldk; const bf16_t* gv_ = gVT + (jt) * 64; \
        _Pragma("unroll") for (int i = 0; i < NKI; ++i) __builtin_amdgcn_global_load_lds((const unsigned*)(gk_ + koff[i]), (__attribute__((address_space(3))) unsigned*)(sb_ + i * 4096), 16, 0, 0); \
        _Pragma("unroll") for (int i = 0; i < NVI; ++i) __builtin_amdgcn_global_load_lds((const unsigned*)(gv_ + voff[i]), (__attribute__((address_space(3))) unsigned*)(sb_ + KB + i * 4096), 16, 0, 0); } while (0)
    int j = __ffsll((long long)tiles) - 1; tiles &= tiles - 1;
    FL_ISSUE(0, j);
    asm volatile("s_waitcnt vmcnt(0)" ::: "memory");
    __syncthreads();
    int cur = 0;
    const int kswz = (KW == 64) ? ((fr >> 1) & 7) : fr;
    const int vswz = (fr >> 1) & 7;
    while (true) {
        int jn = -1;
        if (tiles) { jn = __ffsll((long long)tiles) - 1; tiles &= tiles - 1; FL_ISSUE(cur ^ 1, jn); }
        const char* sK = smem + cur * BUFB;
        const char* sV = smem + cur * BUFB + KB;
        f32x4 s[2][4];
        const float mref0 = (mrow[0] < -1e29f) ? 0.f : mrow[0], mref1 = (mrow[1] < -1e29f) ? 0.f : mrow[1];
        const float ci0 = (SEL && !((((const u64*)(smem + 69632))[fr] >> j) & 1ull)) ? -1e30f : -mref0;
        const float ci1 = (SEL && !((((const u64*)(smem + 69632))[16 + fr] >> j) & 1ull)) ? -1e30f : -mref1;
        const f32x4 cinit0 = (f32x4){ci0, ci0, ci0, ci0}, cinit1 = (f32x4){ci1, ci1, ci1, ci1};
#pragma unroll
        for (int tt = 0; tt < 4; ++tt) {
            const int kr = 32 * (tt >> 1) + (fr >> 2) * 8 + (tt & 1) * 4 + (fr & 3);
            const bf16x8 kf0 = *(const bf16x8*)(sK + kr * KROWB + (((kcol >> 3) + fq) ^ kswz) * 16);
            const bf16x8 kf1 = *(const bf16x8*)(sK + kr * KROWB + (((kcol >> 3) + 4 + fq) ^ kswz) * 16);
            s[0][tt] = mfma16(kf0, qf[0][0], cinit0);
            s[1][tt] = mfma16(kf0, qf[1][0], cinit1);
            s[0][tt] = mfma16(kf1, qf[0][1], s[0][tt]);
            s[1][tt] = mfma16(kf1, qf[1][1], s[1][tt]);
        }
        const bool pm = (j * 64 + 63 > tmin) || (j * 64 <= lomax);
        bf16x8 pf[2][2];
#pragma unroll
        for (int qt = 0; qt < 2; ++qt) {
            if (pm) {
                const bool selok = SEL ? (((((const u64*)(smem + 69632))[qt * 16 + fr] >> j) & 1ull) != 0) : true;
                const int t = tpos[qt], lw = lo[qt];
#pragma unroll
                for (int tt = 0; tt < 4; ++tt)
#pragma unroll
                    for (int jj = 0; jj < 4; ++jj) {
                        const int kp = j * 64 + 32 * (tt >> 1) + fq * 8 + (tt & 1) * 4 + jj;
                        const bool ok = selok && (kp <= t) && (kp > lw);
                        s[qt][tt][jj] = ok ? s[qt][tt][jj] : -1e30f;
                    }
            }
            float mx = fmaxf(fmaxf(s[qt][0][0], s[qt][0][1]), fmaxf(s[qt][0][2], s[qt][0][3]));
#pragma unroll
            for (int tt = 1; tt < 4; ++tt) mx = fmaxf(mx, fmaxf(fmaxf(s[qt][tt][0], s[qt][tt][1]), fmaxf(s[qt][tt][2], s[qt][tt][3])));
            const float mref = qt ? mref1 : mref0;
            if (__builtin_amdgcn_ballot_w64(mx > (mrow[qt] - mref) + 8.0f) != 0ull) {
                mx = fmaxf(mx, __shfl_xor(mx, 16));
                mx = fmaxf(mx, __shfl_xor(mx, 32));
                const float mnew = fmaxf(mrow[qt], mx + mref);
                const float alpha = __builtin_amdgcn_exp2f(mrow[qt] - mnew);
                const float delta = ((mnew < -1e29f) ? 0.f : mnew) - mref;
                lrow[qt] *= alpha;
                mrow[qt] = mnew;
#pragma unroll
                for (int dt = 0; dt < VD / 16; ++dt) O[qt][dt] = O[qt][dt] * alpha;
#pragma unroll
                for (int tt = 0; tt < 4; ++tt)
#pragma unroll
                    for (int jj = 0; jj < 4; ++jj) s[qt][tt][jj] -= delta;
            }
            float ps = 0.f;
#pragma unroll
            for (int tt = 0; tt < 4; ++tt)
#pragma unroll
                for (int jj = 0; jj < 4; ++jj) { s[qt][tt][jj] = __builtin_amdgcn_exp2f(s[qt][tt][jj]); ps += s[qt][tt][jj]; }
            lrow[qt] += ps;
#pragma unroll
            for (int i = 0; i < 2; ++i) {
                u32x4 pk;
                pk.x = cvt_pk_bf16(s[qt][2 * i][0], s[qt][2 * i][1]); pk.y = cvt_pk_bf16(s[qt][2 * i][2], s[qt][2 * i][3]);
                pk.z = cvt_pk_bf16(s[qt][2 * i + 1][0], s[qt][2 * i + 1][1]); pk.w = cvt_pk_bf16(s[qt][2 * i + 1][2], s[qt][2 * i + 1][3]);
                pf[qt][i] = __builtin_bit_cast(bf16x8, pk);
            }
        }
#pragma unroll
        for (int i = 0; i < 2; ++i) {
#pragma unroll
            for (int dt = 0; dt < VD / 16; ++dt) {
                const bf16x8 vf = *(const bf16x8*)(sV + (dt * 16 + fr) * 128 + ((i * 4 + fq) ^ vswz) * 16);
                O[0][dt] = mfma16(vf, pf[0][i], O[0][dt]);
                O[1][dt] = mfma16(vf, pf[1][i], O[1][dt]);
            }
        }
        asm volatile("s_waitcnt vmcnt(0)" ::: "memory");
        __syncthreads();
        if (jn < 0) break;
        j = jn; cur ^= 1;
    }
#undef FL_ISSUE
#pragma unroll
    for (int qt = 0; qt < 2; ++qt) { lrow[qt] += __shfl_xor(lrow[qt], 16); lrow[qt] += __shfl_xor(lrow[qt], 32); }
}

__device__ __forceinline__ float sigmoidf_(float x) { return __builtin_amdgcn_rcpf(1.0f + __expf(-x)); }
__device__ __forceinline__ void nsa_tile(const Params& p, int qb, int bg, char* smem) {
    int tid = threadIdx.x; asm volatile("" : "+v"(tid));
    const int lane = tid & 63, w = tid >> 6, fr = lane & 15, fq = lane >> 4;
    const int b = bg >> 2, g = bg & 3, t0 = qb * 32, hq = g * 4 + w;
    const bf16_t* projA = (const bf16_t*)(p.ws + OFF_PROJA);
    const bf16_t* projVT = (const bf16_t*)(p.ws + OFF_PROJVT);
    float* part = (float*)(smem + 36864);
    u64* selmask = (u64*)(smem + 69632);
    for (int i = tid; i < 2048; i += 256) ((f32x4*)part)[i] = zero4();
    bf16x8 qf[2][2];
    int tpos[2];
    float glog[2][3];
#define NSA_GATE(qt, br) sigmoidf_(glog[qt][br])
    const bf16_t* qbase = projA + (size_t)(b * S + t0) * LDA;
#pragma unroll
    for (int qt = 0; qt < 2; ++qt) {
        tpos[qt] = t0 + qt * 16 + fr;
        const bf16_t* qrow = qbase + (size_t)(qt * 16 + fr) * LDA;
#pragma unroll
        for (int ks = 0; ks < 2; ++ks) qf[qt][ks] = *(const bf16x8*)(qrow + hq * 64 + ks * 32 + fq * 8);
#pragma unroll
        for (int br = 0; br < 3; ++br) glog[qt][br] = __uint_as_float(((unsigned)qrow[2048 + hq * 3 + br]) << 16);
    }
    f32x4 outacc[2][4];
    {
        const bf16_t* kcg = (const bf16_t*)(p.ws + OFF_KC) + (size_t)bg * 256 * 64;
        const int nkp0 = (qb >> 4) + 1;
        for (int i = 0; i < nkp0; ++i) {
            const int q = w + 4 * i, row = q * 8 + (lane >> 3), cp = lane & 7;
            const int f = ((row >> 1) & 1) | (((row >> 3) & 1) << 1) | (((row >> 4) & 1) << 2);
            __builtin_amdgcn_global_load_lds((const unsigned*)(kcg + row * 64 + (cp ^ f) * 8), (__attribute__((address_space(3))) unsigned*)(smem + q * 1024), 16, 0, 0);
        }
        asm volatile("s_waitcnt vmcnt(0)" ::: "memory");
    }
    __syncthreads();
    {
        const bf16_t* vct = (const bf16_t*)(p.ws + OFF_VCT) + (size_t)bg * 64 * 256;
        const int nkp = (qb >> 4) + 1;
        float mc[2] = {-1e30f, -1e30f}, lc[2] = {0.f, 0.f};
#pragma unroll 2
        for (int i = 0; i < nkp; ++i) {
#pragma unroll
            for (int half = 0; half < 2; ++half) {
                const int kr = 32 * i + (fr >> 2) * 8 + half * 4 + (fr & 3);
                f32x4 s0 = zero4(), s1 = zero4();
#pragma unroll
                for (int ks = 0; ks < 2; ++ks) {
                    const bf16x8 kf = *(const bf16x8*)(smem + kr * 128 + ((ks * 4 + fq) ^ ((fr >> 1) & 7)) * 16);
                    s0 = mfma16(kf, qf[0][ks], s0);
                    s1 = mfma16(kf, qf[1][ks], s1);
                }
#pragma unroll
                for (int qt = 0; qt < 2; ++qt) {
                    const f32x4 sv = qt ? s1 : s0;
                    float mx = -1e30f; float vals[4];
#pragma unroll
                    for (int jj = 0; jj < 4; ++jj) {
                        const int nn = 32 * i + fq * 8 + half * 4 + jj;
                        vals[jj] = (16 * nn + 31 <= tpos[qt]) ? sv[jj] : -1e30f;
                        mx = fmaxf(mx, vals[jj]);
                    }
                    mx = fmaxf(mx, __shfl_xor(mx, 16));
                    mx = fmaxf(mx, __shfl_xor(mx, 32));
                    const float mnew = fmaxf(mc[qt], mx);
                    float ps = 0.f;
#pragma unroll
                    for (int jj = 0; jj < 4; ++jj) ps += __builtin_amdgcn_exp2f(vals[jj] - mnew);
                    ps += __shfl_xor(ps, 16);
                    ps += __shfl_xor(ps, 32);
                    lc[qt] = lc[qt] * __builtin_amdgcn_exp2f(mc[qt] - mnew) + ps;
                    mc[qt] = mnew;
                }
            }
        }
        const float il[2] = {1.0f / lc[0], 1.0f / lc[1]};
        f32x4 Oc[2][4];
#pragma unroll
        for (int qt = 0; qt < 2; ++qt)
#pragma unroll
            for (int dt = 0; dt < 4; ++dt) Oc[qt][dt] = zero4();
        float carry[2] = {0.f, 0.f};
#pragma unroll 2
        for (int i = 0; i < nkp; ++i) {
            f32x4 pr[2][2];
#pragma unroll
            for (int half = 0; half < 2; ++half) {
                const int kr = 32 * i + (fr >> 2) * 8 + half * 4 + (fr & 3);
                f32x4 s0 = zero4(), s1 = zero4();
#pragma unroll
                for (int ks = 0; ks < 2; ++ks) {
                    const bf16x8 kf = *(const bf16x8*)(smem + kr * 128 + ((ks * 4 + fq) ^ ((fr >> 1) & 7)) * 16);
                    s0 = mfma16(kf, qf[0][ks], s0);
                    s1 = mfma16(kf, qf[1][ks], s1);
                }
#pragma unroll
                for (int qt = 0; qt < 2; ++qt) {
                    const f32x4 sv = qt ? s1 : s0;
#pragma unroll
                    for (int jj = 0; jj < 4; ++jj) {
                        const int nn = 32 * i + fq * 8 + half * 4 + jj;
                        pr[qt][half][jj] = (16 * nn + 31 <= tpos[qt]) ? __builtin_amdgcn_exp2f(sv[jj] - mc[qt]) * il[qt] : 0.f;
                    }
                }
            }
            bf16x8 pfc[2];
#pragma unroll
            for (int qt = 0; qt < 2; ++qt) {
                const float a0 = (pr[qt][0][0] + pr[qt][0][1]) + (pr[qt][0][2] + pr[qt][0][3]);
                const float a1 = (pr[qt][1][0] + pr[qt][1][1]) + (pr[qt][1][2] + pr[qt][1][3]);
                const float e0 = pr[qt][0][3], e1 = pr[qt][1][3];
                const float up = __shfl(e1, (lane + 48) & 63);
                const float c0 = a0 + (fq == 0 ? carry[qt] : up);
                const float c1 = a1 + e0;
                carry[qt] = __shfl(e1, fr + 48);
                float* dst = part + ((w * 32 + qt * 16 + fr) * 64 + 8 * i + 2 * fq);
                *(float2*)dst = make_float2(c0, c1);
                u32x4 pk;
                pk.x = cvt_pk_bf16(pr[qt][0][0], pr[qt][0][1]); pk.y = cvt_pk_bf16(pr[qt][0][2], pr[qt][0][3]);
                pk.z = cvt_pk_bf16(pr[qt][1][0], pr[qt][1][1]); pk.w = cvt_pk_bf16(pr[qt][1][2], pr[qt][1][3]);
                pfc[qt] = __builtin_bit_cast(bf16x8, pk);
            }
#pragma unroll
            for (int dt = 0; dt < 4; ++dt) {
                const bf16x8 vf = *(const bf16x8*)(vct + ((size_t)(2 * i + (fq >> 1)) * 64 + dt * 16 + fr) * 16 + (fq & 1) * 8);
                Oc[0][dt] = mfma16(vf, pfc[0], Oc[0][dt]);
                Oc[1][dt] = mfma16(vf, pfc[1], Oc[1][dt]);
            }
        }
#pragma unroll
        for (int qt = 0; qt < 2; ++qt) {
            const float gq = NSA_GATE(qt, 0);
#pragma unroll
            for (int dt = 0; dt < 4; ++dt) outacc[qt][dt] = Oc[qt][dt] * gq;
        }
    }
    __syncthreads();
    {
        for (int tt = 0; tt < 8; ++tt) {
            const int tok = w * 8 + tt, t = t0 + tok, cur = t >> 6;
            float v = (part[(0 * 32 + tok) * 64 + lane] + part[(1 * 32 + tok) * 64 + lane]) + (part[(2 * 32 + tok) * 64 + lane] + part[(3 * 32 + tok) * 64 + lane]);
            const bool forced = (lane == 0) || (lane == cur) || (lane == cur - 1);
            const bool future = lane > cur;
            v = forced ? 1e9f : (future ? -1e9f : v);
            int cnt = 0;
#pragma unroll
            for (int i = 0; i < 64; ++i) {
                const float vi = __uint_as_float(__builtin_amdgcn_readlane(__float_as_uint(v), i));
                cnt += ((vi > v) || (vi == v && i < lane)) ? 1 : 0;
            }
            const u64 mk = __ballot((cnt < 16) && !future);
            if (lane == 0) selmask[tok] = mk;
        }
    }
    __syncthreads();
    u64 ormask = 0;
#pragma unroll 4
    for (int i = 0; i < 32; ++i) ormask |= selmask[i];
    ormask = ((u64)__builtin_amdgcn_readfirstlane((unsigned)(ormask >> 32)) << 32) | (u64)__builtin_amdgcn_readfirstlane((unsigned)ormask);
    const u64 selm[2] = {~0ull, ~0ull};
    const int cur0 = t0 >> 6;
    float* park = part;
    __syncthreads();
#pragma unroll
    for (int qt = 0; qt < 2; ++qt)
#pragma unroll
        for (int dt = 0; dt < 4; ++dt)
            ((f32x4*)park)[(qt * 4 + dt) * 256 + tid] = outacc[qt][dt];
    {
        f32x4 O[2][4];
#pragma unroll
        for (int qt = 0; qt < 2; ++qt)
#pragma unroll
            for (int dt = 0; dt < 4; ++dt) O[qt][dt] = zero4();
        float mr[2] = {-1e30f, -1e30f}, lr[2] = {0.f, 0.f};
        const int lo[2] = {-1, -1};
        flash_branch<64, 64, true>(ormask, projA + (size_t)b * S * LDA + 1536 + g * 64, LDA, projVT + ((size_t)b * 512 + g * 64) * S, 0,
                                   qf, O, mr, lr, tpos, selm, lo, t0, -1, smem);
#pragma unroll
        for (int qt = 0; qt < 2; ++qt) {
            const float sc = NSA_GATE(qt, 1) / lr[qt];
#pragma unroll
            for (int dt = 0; dt < 4; ++dt) ((f32x4*)park)[(qt * 4 + dt) * 256 + tid] = ((f32x4*)park)[(qt * 4 + dt) * 256 + tid] + O[qt][dt] * sc;
        }
    }
    {
        f32x4 O[2][4];
#pragma unroll
        for (int qt = 0; qt < 2; ++qt)
#pragma unroll
            for (int dt = 0; dt < 4; ++dt) O[qt][dt] = zero4();
        float mr[2] = {-1e30f, -1e30f}, lr[2] = {0.f, 0.f};
        const int lo[2] = {tpos[0] - 512, tpos[1] - 512};
        const u64 ones[2] = {~0ull, ~0ull};
        int jlo = t0 - 511; jlo = jlo < 0 ? 0 : (jlo >> 6);
        const u64 upto = (cur0 == 63) ? ~0ull : ((1ull << (cur0 + 1)) - 1ull);
        const u64 tiles = upto & ~((1ull << jlo) - 1ull);
        flash_branch<64, 64, false>(tiles, projA + (size_t)b * S * LDA + 1792 + g * 64, LDA, projVT + ((size_t)b * 512 + 256 + g * 64) * S, 0,
                                    qf, O, mr, lr, tpos, ones, lo, t0, t0 + 31 - 512, smem);
#pragma unroll
        for (int qt = 0; qt < 2; ++qt) {
            const float sc = NSA_GATE(qt, 2) / lr[qt];
            bf16_t* ao = (bf16_t*)(p.ws + OFF_ATTN) + (size_t)(b * S + tpos[qt]) * D + hq * 64 + fq * 4;
#pragma unroll
            for (int dt = 0; dt < 4; ++dt) {
                const f32x4 r = ((f32x4*)park)[(qt * 4 + dt) * 256 + tid] + O[qt][dt] * sc;
                *(u32x2*)(ao + dt * 16) = pack4(r);
            }
        }
    }
    __syncthreads();
}

__device__ __forceinline__ void diff_tile(const Params& p, int qb, int bh, float lam, char* smem) {
    int tid = threadIdx.x; asm volatile("" : "+v"(tid));
    const int lane = tid & 63, w = tid >> 6, fr = lane & 15, fq = lane >> 4;
    const int b = bh >> 3, h = bh & 7, map = w >> 1, half = w & 1, tw0 = qb * 64 + half * 32;
    const bf16_t* projA = (const bf16_t*)(p.ws + OFF_PROJA);
    const bf16_t* projVT = (const bf16_t*)(p.ws + OFF_PROJVT);
    bf16x8 qf[2][2];
    int tpos[2];
#pragma unroll
    for (int qt = 0; qt < 2; ++qt) {
        tpos[qt] = tw0 + qt * 16 + fr;
        const bf16_t* qrow = projA + (size_t)(b * S + tpos[qt]) * LDA + (h * 2 + map) * 64;
#pragma unroll
        for (int ks = 0; ks < 2; ++ks) qf[qt][ks] = *(const bf16x8*)(qrow + ks * 32 + fq * 8);
    }
    f32x4 O[2][8];
#pragma unroll
    for (int qt = 0; qt < 2; ++qt)
#pragma unroll
        for (int dt = 0; dt < 8; ++dt) O[qt][dt] = zero4();
    float mr[2] = {-1e30f, -1e30f}, lr[2] = {0.f, 0.f};
    const int lo[2] = {-1, -1};
    const u64 ones[2] = {~0ull, ~0ull};
    const u64 tiles = (qb == 63) ? ~0ull : ((1ull << (qb + 1)) - 1ull);
    flash_branch<128, 128, false>(tiles, projA + (size_t)b * S * LDA + 1024 + h * 128, LDA, projVT + ((size_t)b * 1024 + h * 128) * S, map * 64,
                                  qf, O, mr, lr, tpos, ones, lo, qb * 64, -1, smem);
    float* xch = (float*)smem;
    const float il[2] = {__builtin_amdgcn_rcpf(lr[0]), __builtin_amdgcn_rcpf(lr[1])};
    if (map == 1) {
#pragma unroll
        for (int qt = 0; qt < 2; ++qt)
#pragma unroll
            for (int dt = 0; dt < 8; ++dt) *(f32x4*)(xch + (half * 32 + qt * 16 + fr) * 132 + dt * 16 + fq * 4) = O[qt][dt] * il[qt];
    }
    __syncthreads();
    if (map == 0) {
        const float* sg = p.in[16];
        bf16_t* ao = (bf16_t*)(p.ws + OFF_ATTN);
#pragma unroll
        for (int qt = 0; qt < 2; ++qt) {
            float ss = 0.f;
#pragma unroll
            for (int dt = 0; dt < 8; ++dt) {
                const f32x4 o2 = *(const f32x4*)(xch + (half * 32 + qt * 16 + fr) * 132 + dt * 16 + fq * 4);
#pragma unroll
                for (int j = 0; j < 4; ++j) {
                    const float o = O[qt][dt][j] * il[qt] - lam * o2[j];
                    O[qt][dt][j] = o; ss += o * o;
                }
            }
            ss += __shfl_xor(ss, 16);
            ss += __shfl_xor(ss, 32);
            const float r = rsqrtf(ss * (1.0f / 128.0f) + EPS) * (1.0f - LAMBDA_INIT);
#pragma unroll
            for (int dt = 0; dt < 8; ++dt) {
                const f32x4 gv = *(const f32x4*)(sg + dt * 16 + fq * 4);
                *(u32x2*)(ao + (size_t)(b * S + tpos[qt]) * D + h * 128 + dt * 16 + fq * 4) = pack4(O[qt][dt] * r * gv);
            }
        }
    }
    __syncthreads();
}

constexpr size_t OFF_BAR = 52 * MiB + 512 * 1024;
#define XB_TMO      128
#define XB_XCNT(j)  (256  + 64 * (j))
#define XB_XSUB(j)  (1280 + 64 * (j))
#define XB_XGEN(j)  (2304 + 64 * (j))
#define XB_TOP      3328
#define XB_TOPGEN   3392
#define XCD_BAR_WORDS 3456
#define XB_SPIN_CAP (1u << 23)
#define LAS __attribute__((address_space(3)))
__device__ __forceinline__ unsigned xb_ld(unsigned* p)              { return __hip_atomic_load(p, __ATOMIC_RELAXED, __HIP_MEMORY_SCOPE_AGENT); }
__device__ __forceinline__ unsigned xb_add(unsigned* p, unsigned v) { return __hip_atomic_fetch_add(p, v, __ATOMIC_RELAXED, __HIP_MEMORY_SCOPE_AGENT); }
__device__ __forceinline__ unsigned xb_xcc_id() { return (unsigned)__builtin_amdgcn_s_getreg((3 << 11) | 20) & 0xFu; }
#define XB_SPIN(cond, bar) do { unsigned _sp = 0; while (cond) { __builtin_amdgcn_s_sleep(1); \
    if ((++_sp & 255u) == 0u) { if (xb_ld(&(bar)[XB_TMO])) break; if (_sp > XB_SPIN_CAP) { atomicAdd(&(bar)[XB_TMO], 1u); break; } } } } while (0)
struct XcdBarrier { unsigned* bar; unsigned x; volatile LAS unsigned* st; };
__device__ __forceinline__ XcdBarrier xcd_barrier_post(unsigned* bar, volatile LAS unsigned* st) {
    XcdBarrier b; b.bar = bar; b.x = xb_xcc_id(); b.st = st;
    if (threadIdx.x == 0) (void)xb_add(&bar[XB_XCNT(b.x)], 1u);
    return b;
}
__device__ __forceinline__ void xcd_barrier_complete(unsigned* bar, unsigned x, unsigned& nloc, unsigned& nx) {
    const unsigned G = gridDim.x * gridDim.y * gridDim.z;
    unsigned sum, cnt, mine, sp = 0u;
    for (;;) {
        sum = 0u; cnt = 0u; mine = 0u;
#pragma unroll
        for (unsigned j = 0; j < 16; ++j) { const unsigned c = xb_ld(&bar[XB_XCNT(j)]); sum += c; cnt += (c > 0u) ? 1u : 0u; mine = (j == x) ? c : mine; }
        if (sum == G) break;
        __builtin_amdgcn_s_sleep(1);
        if ((++sp & 255u) == 0u) { if (xb_ld(&bar[XB_TMO])) break; if (sp > XB_SPIN_CAP) { atomicAdd(&bar[XB_TMO], 1u); break; } }
    }
    nloc = mine > 0u ? mine : 1u; nx = cnt > 0u ? cnt : 1u;
}
__device__ __forceinline__ void gsync(const XcdBarrier& b) {
    asm volatile("s_waitcnt vmcnt(0) lgkmcnt(0)" ::: "memory");
    __syncthreads();
    if (threadIdx.x == 0) {
        unsigned* bar = b.bar; unsigned bx = b.x;
        asm volatile("" : "+s"(bar), "+s"(bx));
        __builtin_amdgcn_s_waitcnt(0);
        unsigned nloc = b.st[0], nx = b.st[1];
        if (nloc == 0u) { xcd_barrier_complete(bar, bx, nloc, nx); b.st[0] = nloc; b.st[1] = nx; }
        const unsigned old = xb_add(&bar[XB_XSUB(bx)], 1u);
        const unsigned gen = old / nloc;
        if (old + 1u == (gen + 1u) * nloc) {
            __builtin_amdgcn_fence(__ATOMIC_RELEASE, "agent");
            asm volatile("s_waitcnt vmcnt(0)" ::: "memory");
            const unsigned og = xb_add(&bar[XB_TOP], 1u);
            const unsigned tg = og / nx;
            if (og + 1u == (tg + 1u) * nx) xb_add(&bar[XB_TOPGEN], 1u);
            else XB_SPIN(xb_ld(&bar[XB_TOPGEN]) == tg, bar);
            __builtin_amdgcn_fence(__ATOMIC_ACQUIRE, "agent");
            xb_add(&bar[XB_XGEN(bx)], 1u);
            asm volatile("s_waitcnt vmcnt(0)" ::: "memory");
        } else {
            XB_SPIN(xb_ld(&bar[XB_XGEN(bx)]) == gen, bar);
            __builtin_amdgcn_fence(__ATOMIC_ACQUIRE, "agent");
            asm volatile("s_waitcnt vmcnt(0)" ::: "memory");
        }
    }
    __syncthreads();
}
__global__ void __launch_bounds__(256, 2) fwd_megakernel(Params p) {
    __shared__ __attribute__((aligned(16))) char smem[SMEM_BYTES];
    __shared__ uint4 xb_words;
    cg::grid_group grid = cg::this_grid();
    if (p.ws == nullptr) grid.sync();
    if (threadIdx.x == 0) xb_words = make_uint4(0u, 0u, 0u, 0u);
    __syncthreads();
    const XcdBarrier xb = xcd_barrier_post((unsigned*)(p.ws + OFF_BAR), (volatile LAS unsigned*)&xb_words);
    bf16_t* WT = (bf16_t*)(p.ws + OFF_WT);
    const float* rope = (const float*)(p.ws + OFF_ROPE);
    bf16_t* xn = (bf16_t*)(p.ws + OFF_XN);
    bf16_t* projA = (bf16_t*)(p.ws + OFF_PROJA);
    bf16_t* projVT = (bf16_t*)(p.ws + OFF_PROJVT);
    bf16_t* attn = (bf16_t*)(p.ws + OFF_ATTN);
    bf16_t* hid = (bf16_t*)(p.ws + OFF_HID);
    const int G = gridDim.x;

    prologue_phase(p, smem);
    rmsnorm_phase(p.in[0], p.in[1], xn, nullptr);
    gsync(xb);
    {
        EpiProj e1{projA, LDA, 1536, rope};
        EpiVT e2{projVT, 512};
        gemm_phase2(xn, WT + WT_NSA_IN, T, 2176, e1, WT + WT_NSA_IN + (size_t)2176 * 1024, xn, 512, T, e2, 1024, smem);
    }
    gsync(xb);
    for (int task = blockIdx.x; task < 1024; task += G) compress_task(p, task, smem);
    gsync(xb);
    for (int r = 0; r * G < 4096; ++r) {
        const int k = (r & 1) ? (G - 1 - (int)blockIdx.x) : (int)blockIdx.x, i = r * G + k;
        if (i < 4096) nsa_tile(p, 127 - (i >> 5), i & 31, smem);
    }
    gsync(xb);
    { EpiResid e{p.in[0], p.out}; gemm_phase(attn, WT + WT_NSA_OUT, T, 1024, 1024, e, smem); }
    gsync(xb);
    rmsnorm_phase(p.out, p.in[2], xn, nullptr);
    gsync(xb);
    { EpiSqRelu e{hid}; gemm_phase(xn, WT + WT_UP0, T, FF, 1024, e, smem); }
    gsync(xb);
    { EpiResid e{p.out, p.out}; gemm_phase(hid, WT + WT_DN0, T, 1024, FF, e, smem); }
    gsync(xb);
    rmsnorm_phase(p.out, p.in[1] + D, xn, nullptr);
    gsync(xb);
    {
        EpiProj e1{projA, LDA, 1024, rope};
        EpiVT e2{projVT, 1024};
        gemm_phase2(xn, WT + WT_DIFF_IN, T, 2048, e1, WT + WT_DIFF_IN + (size_t)2048 * 1024, xn, 1024, T, e2, 1024, smem);
    }
    gsync(xb);
    {
        const int lane = threadIdx.x & 63;
        float a = p.in[12][lane] * p.in[13][lane], c = p.in[14][lane] * p.in[15][lane];
#pragma unroll
        for (int o = 32; o >= 1; o >>= 1) { a += __shfl_xor(a, o); c += __shfl_xor(c, o); }
        const float lam = expf(a) - expf(c) + LAMBDA_INIT;
        for (int r = 0; r * G < 4096; ++r) {
            const int k = (r & 1) ? (G - 1 - (int)blockIdx.x) : (int)blockIdx.x, i = r * G + k;
            if (i < 4096) diff_tile(p, 63 - (i >> 6), i & 63, lam, smem);
        }
    }
    gsync(xb);
    { EpiResid e{p.out, p.out}; gemm_phase(attn, WT + WT_DIFF_OUT, T, 1024, 1024, e, smem); }
    gsync(xb);
    rmsnorm_phase(p.out, p.in[2] + D, xn, nullptr);
    gsync(xb);
    { EpiSqRelu e{hid}; gemm_phase(xn, WT + WT_UP1, T, FF, 1024, e, smem); }
    gsync(xb);
    { EpiResid e{p.out, p.out}; gemm_phase(hid, WT + WT_DN1, T, 1024, FF, e, smem); }
    gsync(xb);
    rmsnorm_phase(p.out, p.in[20], nullptr, p.out);
}

extern "C" void kernel_launch(void* const* d_in, const int* in_sizes, int n_in, void* d_out, int out_size, void* d_ws, size_t ws_size, hipStream_t stream) {
    static int grid_blocks = 0;
    if (!grid_blocks) {
        int dev = 0, cus = 0, per_cu = 0;
        hipGetDevice(&dev);
        hipDeviceGetAttribute(&cus, hipDeviceAttributeMultiprocessorCount, dev);
        hipOccupancyMaxActiveBlocksPerMultiprocessor(&per_cu, fwd_megakernel, 256, 0);
        if (per_cu > 2) per_cu = 2;
        grid_blocks = cus * per_cu;
    }
    if (ws_size < WS_NEED) { fprintf(stderr, "workspace too small: %zu < %zu\n", ws_size, (size_t)WS_NEED); return; }
    Params p{};
    for (int i = 0; i < 21; ++i) p.in[i] = (const float*)d_in[i];
    p.out = (float*)d_out;
    p.ws = (char*)d_ws;
    hipMemsetAsync((char*)d_ws + OFF_BAR, 0, XCD_BAR_WORDS * 4, stream);
    void* args[] = {&p};
    hipError_t e = hipLaunchCooperativeKernel((void*)fwd_megakernel, dim3(grid_blocks), dim3(256), args, 0, stream);
    if (e != hipSuccess) fprintf(stderr, "cooperative launch failed: %s (grid %d)\n", hipGetErrorString(e), grid_blocks);
}
```

```cpp
#include <hip/hip_runtime.h>
#include <hip/hip_cooperative_groups.h>
#include <stdint.h>
#include <cstdio>
namespace cg = cooperative_groups;

typedef unsigned short bf16_t;
typedef short bf16x8 __attribute__((ext_vector_type(8)));
typedef float f32x4 __attribute__((ext_vector_type(4)));
typedef unsigned u32x4 __attribute__((ext_vector_type(4)));
typedef unsigned u32x2 __attribute__((ext_vector_type(2)));
typedef unsigned long long u64;

constexpr int NB = 8, S = 4096, D = 1024, T = NB * S, FF = 4096;
constexpr int LDA = 2176;
constexpr float EPS = 1e-6f;
constexpr float LAMBDA_INIT = 0.35550906759096934f;
constexpr int SMEM_BYTES = 73728;

constexpr size_t MiB = 1048576;
constexpr size_t OFF_WT = 0, OFF_ROPE = 52 * MiB, OFF_KC = 53 * MiB, OFF_VCT = 54 * MiB, OFF_XN = 56 * MiB,
                 OFF_PROJA = 120 * MiB, OFF_PROJVT = 256 * MiB, OFF_ATTN = 320 * MiB, OFF_HID = 120 * MiB, WS_NEED = 384 * MiB;
constexpr size_t WT_NSA_IN = 0, WT_NSA_OUT = 2752512, WT_DIFF_IN = 3801088, WT_DIFF_OUT = 6946816, WT_UP0 = 7995392, WT_UP1 = 12189696,
                 WT_DN0 = 16384000, WT_DN1 = 20578304, WT_CKW1 = 24772608, WT_CVW1 = 25296896, WT_CKW2 = 25821184, WT_CVW2 = 25837568;

struct Params {
    const float* in[21];
    float* out;
    char* ws;
};

typedef __bf16 bf16x2_t __attribute__((ext_vector_type(2)));
typedef float f32x2_t __attribute__((ext_vector_type(2)));
__device__ __forceinline__ unsigned cvt_pk_bf16(float lo, float hi) { const f32x2_t f = {lo, hi}; return __builtin_bit_cast(unsigned, __builtin_convertvector(f, bf16x2_t)); }
__device__ __forceinline__ float bf_lo(unsigned u) { return __uint_as_float(u << 16); }
__device__ __forceinline__ float bf_hi(unsigned u) { return __uint_as_float(u & 0xffff0000u); }
__device__ __forceinline__ u32x2 pack4(f32x4 v) { u32x2 r; r.x = cvt_pk_bf16(v[0], v[1]); r.y = cvt_pk_bf16(v[2], v[3]); return r; }
__device__ __forceinline__ f32x4 mfma16(bf16x8 a, bf16x8 b, f32x4 c) { return __builtin_amdgcn_mfma_f32_16x16x32_bf16(a, b, c, 0, 0, 0); }
__device__ __forceinline__ f32x4 zero4() { return (f32x4){0.f, 0.f, 0.f, 0.f}; }

__device__ __forceinline__ int lds_byte(int r, int c) {
    const int st = (r >> 4) * 2 + (c >> 5), ob = (r & 15) * 64 + (c & 31) * 2;
    return st * 1024 + (ob ^ (((ob >> 9) & 1) << 5));
}
__device__ __forceinline__ void stage_rc(int b, int& R, int& C) {
    const int st = b >> 10, sb = b & 1023, swz = sb ^ (((sb >> 9) & 1) << 5);
    R = (st >> 1) * 16 + swz / 64;
    C = (st & 1) * 32 + (swz % 64) / 2;
}
constexpr int TILE_B = 128 * 64 * 2;
template <class Epi>
__device__ __forceinline__ void gemm_tile(const bf16_t* __restrict__ A, const bf16_t* __restrict__ Bt, int K, int row0, int col0, const Epi& epi, char* smem,
                                          bool prefetched, bool nvalid, int nrow0, int ncol0) {
    const int tid = threadIdx.x, lane = tid & 63, w = tid >> 6, wr = w >> 1, wc = w & 1, fr = lane & 15, fq = lane >> 4;
    f32x4 acc[4][4];
#pragma unroll
    for (int m = 0; m < 4; ++m)
#pragma unroll
        for (int n = 0; n < 4; ++n) acc[m][n] = zero4();
    int soffA[4], soffB[4];
#pragma unroll
    for (int i = 0; i < 4; ++i) {
        const int row = (w + 4 * i) * 8 + (lane >> 3), cp = lane & 7;
        soffA[i] = row * K + (cp ^ ((row >> 1) & 7)) * 8;
        soffB[i] = row * K + (cp ^ (((row >> 1) & 1) | (((row >> 3) & 1) << 1) | (((row >> 4) & 1) << 2))) * 8;
    }
    const bf16_t* pA = A + (size_t)row0 * K;
    const bf16_t* pB = Bt + (size_t)col0 * K;
#define GLDS_STAGE(buf, PA, PB, kt) do { _Pragma("unroll") for (int i = 0; i < 4; ++i) { \
        __builtin_amdgcn_global_load_lds((const unsigned*)((PA) + soffA[i] + (kt) * 64), (__attribute__((address_space(3))) unsigned*)(smem + (buf) * 2 * TILE_B + w * 1024 + i * 4096), 16, 0, 0); \
        __builtin_amdgcn_global_load_lds((const unsigned*)((PB) + soffB[i] + (kt) * 64), (__attribute__((address_space(3))) unsigned*)(smem + (buf) * 2 * TILE_B + TILE_B + w * 1024 + i * 4096), 16, 0, 0); } } while (0)
    int offA[4][2], offB[4][2];
#pragma unroll
    for (int m = 0; m < 4; ++m)
#pragma unroll
        for (int ks = 0; ks < 2; ++ks) { const int cx = ((ks * 4 + fq) ^ ((fr >> 1) & 7)) * 16;
            offA[m][ks] = (wr * 64 + m * 16 + fr) * 128 + cx;
            offB[m][ks] = TILE_B + (wc * 64 + (m >> 1) * 32 + 8 * (fr >> 2) + 4 * (m & 1) + (fr & 3)) * 128 + cx; }
    if (prefetched) {
        if (Epi::STAGED) asm volatile("s_waitcnt vmcnt(8)" ::: "memory");
        else asm volatile("s_waitcnt vmcnt(0)" ::: "memory");
    } else {
        GLDS_STAGE(0, pA, pB, 0);
        asm volatile("s_waitcnt vmcnt(0)" ::: "memory");
    }
    __syncthreads();
    const int nk = K >> 6;
    for (int kt = 0; kt < nk; ++kt) {
        const int cur = kt & 1;
        if (kt + 1 < nk) GLDS_STAGE(cur ^ 1, pA, pB, kt + 1);
        const char* cb = smem + cur * 2 * TILE_B;
#pragma unroll
        for (int ks = 0; ks < 2; ++ks) {
            bf16x8 a[4], b[4];
#pragma unroll
            for (int m = 0; m < 4; ++m) a[m] = *(const bf16x8*)(cb + offA[m][ks]);
#pragma unroll
            for (int n = 0; n < 4; ++n) b[n] = *(const bf16x8*)(cb + offB[n][ks]);
#pragma unroll
            for (int m = 0; m < 4; ++m)
#pragma unroll
                for (int n = 0; n < 4; ++n) acc[m][n] = mfma16(b[n], a[m], acc[m][n]);
        }
        asm volatile("s_waitcnt vmcnt(0)" ::: "memory");
        __syncthreads();
    }
    if (nvalid) { const bf16_t* qA = A + (size_t)nrow0 * K; const bf16_t* qB = Bt + (size_t)ncol0 * K; GLDS_STAGE(0, qA, qB, 0); }
#undef GLDS_STAGE
    if constexpr (Epi::STAGED) {
        bf16_t* st = (bf16_t*)(smem + 2 * TILE_B);
        epi.to_lds(acc, st, row0, col0, wr, wc, fr, fq);
        __syncthreads();
        bf16_t* gbase; size_t gstride;
        epi.dest(row0, col0, gbase, gstride);
        const int r0 = tid >> 4, ch = (tid & 15) * 8;
#pragma unroll
        for (int it = 0; it < 8; ++it) { const int r = it * 16 + r0; __builtin_nontemporal_store(*(const u32x4*)(st + r * 136 + ch), (u32x4*)(gbase + (size_t)r * gstride + ch)); }
    } else {
        epi(acc, row0 + wr * 64, col0 + wc * 64, fr, fq);
    }
    if (!nvalid) { asm volatile("s_waitcnt vmcnt(0) lgkmcnt(0)" ::: "memory"); __syncthreads(); }
}

__device__ __forceinline__ u32x4 pack8(f32x4 a, f32x4 b) { u32x4 r; r.x = cvt_pk_bf16(a[0], a[1]); r.y = cvt_pk_bf16(a[2], a[3]); r.z = cvt_pk_bf16(b[0], b[1]); r.w = cvt_pk_bf16(b[2], b[3]); return r; }
struct EpiProj {
    static constexpr bool STAGED = true;
    bf16_t* out; int ld; int rope_lo2; const float* rope;
    __device__ __forceinline__ void dest(int row0, int col0, bf16_t*& g, size_t& stride) const { g = out + (size_t)row0 * ld + col0; stride = (size_t)ld; }
    __device__ __forceinline__ void to_lds(f32x4 (&acc)[4][4], bf16_t* st, int row0, int col0, int wr, int wc, int fr, int fq) const {
        const int cb = col0 + wc * 64;
        const bool isq = cb < 1024;
        const bool dorope = (cb < 1024) || (cb >= rope_lo2 && cb < 2048);
#pragma unroll
        for (int m = 0; m < 4; ++m) {
            const int rl = wr * 64 + m * 16 + fr;
            const int s = (row0 + rl) & (S - 1);
#pragma unroll
            for (int pp = 0; pp < 2; ++pp) {
                f32x4 v0 = acc[m][2 * pp], v1 = acc[m][2 * pp + 1];
                if (pp == 0 && dorope) {
                    f32x4 p0, p1;
#pragma unroll
                    for (int j = 0; j < 4; ++j) { p0[j] = __shfl_xor(v0[j], 16); p1[j] = __shfl_xor(v1[j], 16); }
                    const float* rp = rope + s * 16;
                    const f32x4 c0 = *(const f32x4*)rp, c1 = *(const f32x4*)(rp + 4), s0 = *(const f32x4*)(rp + 8), s1 = *(const f32x4*)(rp + 12);
                    if (fq == 0) { v0 = v0 * c0 - p0 * s0; v1 = v1 * c1 - p1 * s1; }
                    else if (fq == 1) { v0 = v0 * c0 + p0 * s0; v1 = v1 * c1 + p1 * s1; }
                }
                if (isq) { v0 = v0 * 0.18033688011112042f; v1 = v1 * 0.18033688011112042f; }
                *(u32x4*)(st + rl * 136 + wc * 64 + pp * 32 + 8 * fq) = pack8(v0, v1);
            }
        }
    }
};
struct EpiVT {
    static constexpr bool STAGED = true;
    bf16_t* out; int MV;
    __device__ __forceinline__ void dest(int row0, int col0, bf16_t*& g, size_t& stride) const { g = out + ((size_t)(col0 >> 12) * MV + row0) * S + (col0 & (S - 1)); stride = (size_t)S; }
    __device__ __forceinline__ void to_lds(f32x4 (&acc)[4][4], bf16_t* st, int row0, int col0, int wr, int wc, int fr, int fq) const {
#pragma unroll
        for (int m = 0; m < 4; ++m)
#pragma unroll
            for (int pp = 0; pp < 2; ++pp)
                *(u32x4*)(st + (wr * 64 + m * 16 + fr) * 136 + wc * 64 + pp * 32 + 8 * fq) = pack8(acc[m][2 * pp], acc[m][2 * pp + 1]);
    }
};
struct EpiResid {
    static constexpr bool STAGED = false;
    const float* res; float* out;
    __device__ __forceinline__ void operator()(f32x4 (&acc)[4][4], int rb, int cb, int fr, int fq) const {
        f32x4 r[4][2][2];
#pragma unroll
        for (int m = 0; m < 4; ++m)
#pragma unroll
            for (int pp = 0; pp < 2; ++pp) {
                const size_t o = (size_t)(rb + m * 16 + fr) * D + cb + pp * 32 + 8 * fq;
                r[m][pp][0] = __builtin_nontemporal_load((const f32x4*)(res + o));
                r[m][pp][1] = __builtin_nontemporal_load((const f32x4*)(res + o + 4));
            }
#pragma unroll
        for (int m = 0; m < 4; ++m)
#pragma unroll
            for (int pp = 0; pp < 2; ++pp) {
                const size_t o = (size_t)(rb + m * 16 + fr) * D + cb + pp * 32 + 8 * fq;
                *(f32x4*)(out + o) = r[m][pp][0] + acc[m][2 * pp];
                *(f32x4*)(out + o + 4) = r[m][pp][1] + acc[m][2 * pp + 1];
            }
    }
};
struct EpiSqRelu {
    static constexpr bool STAGED = true;
    bf16_t* out;
    __device__ __forceinline__ void dest(int row0, int col0, bf16_t*& g, size_t& stride) const { g = out + (size_t)row0 * FF + col0; stride = (size_t)FF; }
    __device__ __forceinline__ void to_lds(f32x4 (&acc)[4][4], bf16_t* st, int row0, int col0, int wr, int wc, int fr, int fq) const {
#pragma unroll
        for (int m = 0; m < 4; ++m)
#pragma unroll
            for (int pp = 0; pp < 2; ++pp) {
                f32x4 v0 = acc[m][2 * pp], v1 = acc[m][2 * pp + 1];
#pragma unroll
                for (int j = 0; j < 4; ++j) { const float u0 = fmaxf(v0[j], 0.f), u1 = fmaxf(v1[j], 0.f); v0[j] = u0 * u0; v1[j] = u1 * u1; }
                *(u32x4*)(st + (wr * 64 + m * 16 + fr) * 136 + wc * 64 + pp * 32 + 8 * fq) = pack8(v0, v1);
            }
    }
};

template <class Epi>
__device__ __forceinline__ void gemm_phase(const bf16_t* A, const bf16_t* Bt, int M, int N, int K, const Epi& epi, char* smem) {
    const int nN = N >> 7, ntiles = (M >> 7) * nN, G = gridDim.x;
    bool pre = false;
    for (int i = blockIdx.x; i < ntiles; i += G) {
        const int j = i + G; const bool nv = j < ntiles;
        gemm_tile(A, Bt, K, (i / nN) << 7, (i % nN) << 7, epi, smem, pre, nv, (j / nN) << 7, (j % nN) << 7);
        pre = nv;
    }
}
template <class E1, class E2>
__device__ __forceinline__ void gemm_phase2(const bf16_t* A1, const bf16_t* B1, int M1, int N1, const E1& e1,
                                            const bf16_t* A2, const bf16_t* B2, int M2, int N2, const E2& e2, int K, char* smem) {
    gemm_phase(A1, B1, M1, N1, K, e1, smem);
    const int nM2 = M2 >> 7, nt2 = nM2 * (N2 >> 7), G = gridDim.x;
    bool pre = false;
    for (int i = (blockIdx.x + (G >> 1)) % G; i < nt2; i += G) {
        const int j = i + G; const bool nv = j < nt2;
        gemm_tile(A2, B2, K, (i % nM2) << 7, (i / nM2) << 7, e2, smem, pre, nv, (j % nM2) << 7, (j / nM2) << 7);
        pre = nv;
    }
}

__device__ __forceinline__ void rmsnorm_phase(const float* x, const float* g, bf16_t* outb, float* outf) {
    const int lane = threadIdx.x & 63;
    const int gw = blockIdx.x * 4 + (threadIdx.x >> 6), nw = gridDim.x * 4;
    f32x4 gv[4];
#pragma unroll
    for (int i = 0; i < 4; ++i) gv[i] = *(const f32x4*)(g + (lane + i * 64) * 4);
    for (int row = gw; row < T; row += nw) {
        const float* xr = x + (size_t)row * D;
        f32x4 v[4];
        float ss = 0.f;
#pragma unroll
        for (int i = 0; i < 4; ++i) { v[i] = __builtin_nontemporal_load((const f32x4*)(xr + (lane + i * 64) * 4)); ss += v[i][0] * v[i][0] + v[i][1] * v[i][1] + v[i][2] * v[i][2] + v[i][3] * v[i][3]; }
#pragma unroll
        for (int o = 32; o >= 1; o >>= 1) ss += __shfl_xor(ss, o);
        const float r = rsqrtf(ss * (1.0f / D) + EPS);
#pragma unroll
        for (int i = 0; i < 4; ++i) {
            const f32x4 y = v[i] * r * gv[i];
            if (outb) *(u32x2*)(outb + (size_t)row * D + (lane + i * 64) * 4) = pack4(y);
            else __builtin_nontemporal_store(y, (f32x4*)(outf + (size_t)row * D + (lane + i * 64) * 4));
        }
    }
}

__device__ __forceinline__ int nsa_in_rowmap(int n) {
    if (n < 1792) return n;
    if (n < 2048) return 2176 + (n - 1792);
    if (n < 2304) return 1792 + (n - 2048);
    if (n < 2560) return 2176 + 256 + (n - 2304);
    return 2048 + (n - 2560);
}
__device__ __forceinline__ void tr_tile(const float* __restrict__ src, int K, int N, bf16_t* __restrict__ dst, bool remap, int kt, int nt, float* sm) {
    const int tid = threadIdx.x;
    const int r = tid >> 4, c4 = (tid & 15) * 4;
#pragma unroll
    for (int i = 0; i < 4; ++i) {
        const int k = kt * 64 + r + i * 16, n = nt * 64 + c4;
        f32x4 v = zero4();
        if (n < N) v = __builtin_nontemporal_load((const f32x4*)(src + (size_t)k * N + n));
        float* d = sm + (r + i * 16) * 65 + c4;
        d[0] = v[0]; d[1] = v[1]; d[2] = v[2]; d[3] = v[3];
    }
    __syncthreads();
    const int nl = tid >> 2, kc = (tid & 3) * 16, n = nt * 64 + nl;
    if (n < N) {
        const int rr = remap ? nsa_in_rowmap(n) : n;
        unsigned pk[8];
#pragma unroll
        for (int i = 0; i < 8; ++i) pk[i] = cvt_pk_bf16(sm[(kc + 2 * i) * 65 + nl], sm[(kc + 2 * i + 1) * 65 + nl]);
        bf16_t* dp = dst + (size_t)rr * K + kt * 64 + kc;
        *(u32x4*)dp = (u32x4){pk[0], pk[1], pk[2], pk[3]};
        *(u32x4*)(dp + 8) = (u32x4){pk[4], pk[5], pk[6], pk[7]};
    }
    __syncthreads();
}
__device__ __forceinline__ void prologue_phase(const Params& p, char* smem) {
    bf16_t* WT = (bf16_t*)(p.ws + OFF_WT);
    float* sm = (float*)smem;
    constexpr int NJ = 12;
    constexpr int NTR = 656 + 256 + 768 + 256 + 4096 + 256 + 8;
    const int ntask = NTR + 16;
    for (int task = blockIdx.x; task < ntask; task += gridDim.x) {
        if (task < NTR) {
            int t = task; const float* src; int K, N; bf16_t* dst; bool remap = false;
            if (t < 656) { src = p.in[3]; K = 1024; N = 2608; dst = WT + WT_NSA_IN; remap = true; }
            else if ((t -= 656) < 256) { src = p.in[10]; K = 1024; N = 1024; dst = WT + WT_NSA_OUT; }
            else if ((t -= 256) < 768) { src = p.in[11]; K = 1024; N = 3072; dst = WT + WT_DIFF_IN; }
            else if ((t -= 768) < 256) { src = p.in[17]; K = 1024; N = 1024; dst = WT + WT_DIFF_OUT; }
            else if ((t -= 256) < 1024) { src = p.in[18]; K = 1024; N = 4096; dst = WT + WT_UP0; }
            else if ((t -= 1024) < 1024) { src = p.in[18] + (size_t)1024 * 4096; K = 1024; N = 4096; dst = WT + WT_UP1; }
            else if ((t -= 1024) < 1024) { src = p.in[19]; K = 4096; N = 1024; dst = WT + WT_DN0; }
            else if ((t -= 1024) < 1024) { src = p.in[19] + (size_t)4096 * 1024; K = 4096; N = 1024; dst = WT + WT_DN1; }
            else if ((t -= 1024) < 128) { src = p.in[5]; K = 2048; N = 256; dst = WT + WT_CKW1; }
            else if ((t -= 128) < 128) { src = p.in[8]; K = 2048; N = 256; dst = WT + WT_CVW1; }
            else if ((t -= 128) < 4) { src = p.in[6]; K = 256; N = 64; dst = WT + WT_CKW2; }
            else { t -= 4; src = p.in[9]; K = 256; N = 64; dst = WT + WT_CVW2; }
            const int nkt = K >> 6;
            tr_tile(src, K, N, dst, remap, t % nkt, t / nkt, sm);
        } else {
            const int mt = task - NTR;
            float* rope = (float*)(p.ws + OFF_ROPE);
            const float invf[8] = {1.0f, 0.193922758102417f, 0.03760603070259094f, 0.00729266507551074f, 0.001414213445968926f,
                                   0.00027424818836152554f, 5.318296462064609e-05f, 1.0313385246263351e-05f};
            const int pos = mt * 256 + threadIdx.x;
#pragma unroll
            for (int i = 0; i < 8; ++i) {
                const float a = (float)pos * invf[i];
                const double ad = (double)a;
                const double kq = rint(ad * 0.15915494309189535);
                const float rr = (float)(ad - kq * 6.283185307179586);
                rope[pos * 16 + i] = __cosf(rr);
                rope[pos * 16 + 8 + i] = __sinf(rr);
            }
            u32x4* z = (u32x4*)(WT + WT_NSA_IN + (size_t)2096 * 1024);
            for (int i = mt * 256 + threadIdx.x; i < 10240; i += 16 * 256) z[i] = (u32x4){0u, 0u, 0u, 0u};
        }
    }
    (void)NJ;
}

__device__ __forceinline__ float gelu_tanh(float x) {
    const float u = 0.7978845608028654f * (x + 0.044715f * x * x * x);
    const float e = __expf(2.0f * u);
    const float th = 1.0f - 2.0f * __builtin_amdgcn_rcpf(e + 1.0f);
    return 0.5f * x * (1.0f + th);
}
__device__ __forceinline__ void compress_task(const Params& p, int task, char* smem) {
    const int tid = threadIdx.x, lane = tid & 63, w = tid >> 6, fr = lane & 15, fq = lane >> 4;
    const int kv = task >> 9, bg = (task >> 4) & 31, n0 = (task & 15) * 16;
    const int b = bg >> 2, g = bg & 3;
    const bf16_t* WT = (const bf16_t*)(p.ws + OFF_WT);
    const bf16_t* src = (const bf16_t*)(p.ws + OFF_PROJA) + (size_t)b * S * LDA + 1024 + kv * 256 + g * 64;
    const float* pos = kv ? p.in[7] : p.in[4];
    const bf16_t* w1t = WT + (kv ? WT_CVW1 : WT_CKW1);
    const bf16_t* w2t = WT + (kv ? WT_CVW2 : WT_CKW2);
    f32x4 acc[16];
#pragma unroll
    for (int i = 0; i < 16; ++i) acc[i] = zero4();
    const int n = n0 + fr;
#pragma unroll 2
    for (int kq = 0; kq < 16; ++kq) {
        const int kk = w * 16 + kq, l = kk >> 1, d = (kk & 1) * 32 + fq * 8;
        int tok = 16 * n + l; tok = tok < S ? tok : S - 1;
        const u32x4 raw = *(const u32x4*)(src + (size_t)tok * LDA + d);
        const float* pp = pos + l * 64 + d;
        const f32x4 p0 = *(const f32x4*)pp, p1 = *(const f32x4*)(pp + 4);
        u32x4 ap;
        ap.x = cvt_pk_bf16(bf_lo(raw.x) + p0[0], bf_hi(raw.x) + p0[1]);
        ap.y = cvt_pk_bf16(bf_lo(raw.y) + p0[2], bf_hi(raw.y) + p0[3]);
        ap.z = cvt_pk_bf16(bf_lo(raw.z) + p1[0], bf_hi(raw.z) + p1[1]);
        ap.w = cvt_pk_bf16(bf_lo(raw.w) + p1[2], bf_hi(raw.w) + p1[3]);
        const bf16x8 a = __builtin_bit_cast(bf16x8, ap);
#pragma unroll
        for (int nt = 0; nt < 16; ++nt) {
            const bf16x8 bw = *(const bf16x8*)(w1t + (size_t)(nt * 16 + fr) * 2048 + kk * 32 + fq * 8);
            acc[nt] = mfma16(bw, a, acc[nt]);
        }
    }
    float* red = (float*)smem;
    bf16_t* hid = (bf16_t*)(smem + 49920);
    if (w > 0) {
#pragma unroll
        for (int nt = 0; nt < 16; ++nt) *(f32x4*)(red + ((w - 1) * 16 + fr) * 260 + nt * 16 + fq * 4) = acc[nt];
    }
    __syncthreads();
    if (w == 0) {
#pragma unroll
        for (int nt = 0; nt < 16; ++nt) {
            f32x4 v = acc[nt];
#pragma unroll
            for (int ww = 0; ww < 3; ++ww) v = v + *(const f32x4*)(red + (ww * 16 + fr) * 260 + nt * 16 + fq * 4);
#pragma unroll
            for (int j = 0; j < 4; ++j) v[j] = gelu_tanh(v[j]);
            *(u32x2*)(hid + fr * 264 + nt * 16 + fq * 4) = pack4(v);
        }
    }
    __syncthreads();
    f32x4 o = zero4();
#pragma unroll
    for (int kk = 0; kk < 8; ++kk) {
        const bf16x8 hf = *(const bf16x8*)(hid + fr * 264 + kk * 32 + fq * 8);
        const bf16x8 wf = *(const bf16x8*)(w2t + (size_t)(w * 16 + fr) * 256 + kk * 32 + fq * 8);
        if (kv == 0) o = mfma16(wf, hf, o);
        else o = mfma16(hf, wf, o);
    }
    if (kv == 0) {
        bf16_t* kc = (bf16_t*)(p.ws + OFF_KC);
        if (w == 0) {
            const float* rope = (const float*)(p.ws + OFF_ROPE);
            int ps = 16 * n + 31; ps = ps < S ? ps : S - 1;
            f32x4 pv;
#pragma unroll
            for (int j = 0; j < 4; ++j) pv[j] = __shfl_xor(o[j], 32);
            const float* rp = rope + ps * 16 + (fq & 1) * 4;
            const f32x4 c = *(const f32x4*)rp, sn = *(const f32x4*)(rp + 8);
            if (fq < 2) o = o * c - pv * sn; else o = o * c + pv * sn;
        }
        if (n >= 255) o = zero4();
        *(u32x2*)(kc + ((size_t)bg * 256 + n) * 64 + w * 16 + fq * 4) = pack4(o);
    } else {
        bf16_t* vct = (bf16_t*)(p.ws + OFF_VCT);
#pragma unroll
        for (int j = 0; j < 4; ++j) if (n0 + fq * 4 + j >= 255) o[j] = 0.f;
        *(u32x2*)(vct + (((size_t)bg * 16 + (n0 >> 4)) * 64 + w * 16 + fr) * 16 + fq * 4) = pack4(o);
    }
    __syncthreads();
}

template <int KW, int VD, bool SEL>
__device__ __forceinline__ void flash_branch(u64 tiles, const bf16_t* __restrict__ gK, int ldk, const bf16_t* __restrict__ gVT, int kcol,
                                             const bf16x8 (&qf)[2][2], f32x4 (&O)[2][VD / 16], float (&mrow)[2], float (&lrow)[2],
                                             const int (&tpos)[2], const u64 (&selm)[2], const int (&lo)[2], int tmin, int lomax, char* smem) {
    constexpr int KROWB = KW * 2, KB = 64 * KROWB, VB = VD * 128, BUFB = KB + VB;
    constexpr int NKI = KB / 4096, NVI = VB / 4096, KRPI = 1024 / KROWB, KCPR = KROWB / 16;
    int tid = threadIdx.x; asm volatile("" : "+v"(tid));
    const int lane = tid & 63, w = tid >> 6, fr = lane & 15, fq = lane >> 4;
    if (!tiles) return;
    int koff[NKI], voff[NVI];
#pragma unroll
    for (int i = 0; i < NKI; ++i) {
        const int row = (w + 4 * i) * KRPI + lane / KCPR, cp = lane % KCPR;
        const int f = (KW == 64) ? (((row >> 1) & 1) | (((row >> 3) & 1) << 1) | (((row >> 4) & 1) << 2)) : ((row & 3) | (((row >> 3) & 3) << 2));
        koff[i] = row * ldk + (cp ^ f) * 8;
    }
#pragma unroll
    for (int i = 0; i < NVI; ++i) {
        const int row = (w + 4 * i) * 8 + (lane >> 3), cp = lane & 7;
        voff[i] = row * S + (cp ^ ((row >> 1) & 7)) * 8;
    }
#define FL_ISSUE(buf, jt) do { char* sb_ = smem + (buf) * BUFB + w * 1024; const bf16_t* gk_ = gK + (size_t)(jt) * 64 * ldk; const bf16_t* gv_ = gVT + (jt) * 64; \
        _Pragma("unroll") for (int i = 0; i < NKI; ++i) __builtin_amdgcn_global_load_lds((const unsigned*)(gk_ + koff[i]), (__attribute__((address_space(3))) unsigned*)(sb_ + i * 4096), 16, 0, 0); \
        _Pragma("unroll") for (int i = 0; i < NVI; ++i) __builtin_amdgcn_global_load_lds((const unsigned*)(gv_ + voff[i]), (__attribute__((address_space(3))) unsigned*)(sb_ + KB + i * 4096), 16, 0, 0); } while (0)
    int j = __ffsll((long long)tiles) - 1; tiles &= tiles - 1;
    FL_ISSUE(0, j);
    asm volatile("s_waitcnt vmcnt(0)" ::: "memory");
    __syncthreads();
    int cur = 0;
    const int kswz = (KW == 64) ? ((fr >> 1) & 7) : fr;
    const int vswz = (fr >> 1) & 7;
    while (true) {
        int jn = -1;
        if (tiles) { jn = __ffsll((long long)tiles) - 1; tiles &= tiles - 1; FL_ISSUE(cur ^ 1, jn); }
        const char* sK = smem + cur * BUFB;
        const char* sV = smem + cur * BUFB + KB;
        f32x4 s[2][4];
        const float mref0 = (mrow[0] < -1e29f) ? 0.f : mrow[0], mref1 = (mrow[1] < -1e29f) ? 0.f : mrow[1];
        const float ci0 = (SEL && !((((const u64*)(smem + 69632))[fr] >> j) & 1ull)) ? -1e30f : -mref0;
        const float ci1 = (SEL && !((((const u64*)(smem + 69632))[16 + fr] >> j) & 1ull)) ? -1e30f : -mref1;
        const f32x4 cinit0 = (f32x4){ci0, ci0, ci0, ci0}, cinit1 = (f32x4){ci1, ci1, ci1, ci1};
#pragma unroll
        for (int tt = 0; tt < 4; ++tt) {
            const int kr = 32 * (tt >> 1) + (fr >> 2) * 8 + (tt & 1) * 4 + (fr & 3);
            const bf16x8 kf0 = *(const bf16x8*)(sK + kr * KROWB + (((kcol >> 3) + fq) ^ kswz) * 16);
            const bf16x8 kf1 = *(const bf16x8*)(sK + kr * KROWB + (((kcol >> 3) + 4 + fq) ^ kswz) * 16);
            s[0][tt] = mfma16(kf0, qf[0][0], cinit0);
            s[1][tt] = mfma16(kf0, qf[1][0], cinit1);
            s[0][tt] = mfma16(kf1, qf[0][1], s[0][tt]);
            s[1][tt] = mfma16(kf1, qf[1][1], s[1][tt]);
        }
        const bool pm = (j * 64 + 63 > tmin) || (j * 64 <= lomax);
        bf16x8 pf[2][2];
#pragma unroll
        for (int qt = 0; qt < 2; ++qt) {
            if (pm) {
                const bool selok = SEL ? (((((const u64*)(smem + 69632))[qt * 16 + fr] >> j) & 1ull) != 0) : true;
                const int t = tpos[qt], lw = lo[qt];
#pragma unroll
                for (int tt = 0; tt < 4; ++tt)
#pragma unroll
                    for (int jj = 0; jj < 4; ++jj) {
                        const int kp = j * 64 + 32 * (tt >> 1) + fq * 8 + (tt & 1) * 4 + jj;
                        const bool ok = selok && (kp <= t) && (kp > lw);
                        s[qt][tt][jj] = ok ? s[qt][tt][jj] : -1e30f;
                    }
            }
            float mx = fmaxf(fmaxf(s[qt][0][0], s[qt][0][1]), fmaxf(s[qt][0][2], s[qt][0][3]));
#pragma unroll
            for (int tt = 1; tt < 4; ++tt) mx = fmaxf(mx, fmaxf(fmaxf(s[qt][tt][0], s[qt][tt][1]), fmaxf(s[qt][tt][2], s[qt][tt][3])));
            const float mref = qt ? mref1 : mref0;
            if (__builtin_amdgcn_ballot_w64(mx > (mrow[qt] - mref) + 8.0f) != 0ull) {
                mx = fmaxf(mx, __shfl_xor(mx, 16));
                mx = fmaxf(mx, __shfl_xor(mx, 32));
                const float mnew = fmaxf(mrow[qt], mx + mref);
                const float alpha = __builtin_amdgcn_exp2f(mrow[qt] - mnew);
                const float delta = ((mnew < -1e29f) ? 0.f : mnew) - mref;
                lrow[qt] *= alpha;
                mrow[qt] = mnew;
#pragma unroll
                for (int dt = 0; dt < VD / 16; ++dt) O[qt][dt] = O[qt][dt] * alpha;
#pragma unroll
                for (int tt = 0; tt < 4; ++tt)
#pragma unroll
                    for (int jj = 0; jj < 4; ++jj) s[qt][tt][jj] -= delta;
            }
            float ps = 0.f;
#pragma unroll
            for (int tt = 0; tt < 4; ++tt)
#pragma unroll
                for (int jj = 0; jj < 4; ++jj) { s[qt][tt][jj] = __builtin_amdgcn_exp2f(s[qt][tt][jj]); ps += s[qt][tt][jj]; }
            lrow[qt] += ps;
#pragma unroll
            for (int i = 0; i < 2; ++i) {
                u32x4 pk;
                pk.x = cvt_pk_bf16(s[qt][2 * i][0], s[qt][2 * i][1]); pk.y = cvt_pk_bf16(s[qt][2 * i][2], s[qt][2 * i][3]);
                pk.z = cvt_pk_bf16(s[qt][2 * i + 1][0], s[qt][2 * i + 1][1]); pk.w = cvt_pk_bf16(s[qt][2 * i + 1][2], s[qt][2 * i + 1][3]);
                pf[qt][i] = __builtin_bit_cast(bf16x8, pk);
            }
        }
#pragma unroll
        for (int i = 0; i < 2; ++i) {
#pragma unroll
            for (int dt = 0; dt < VD / 16; ++dt) {
                const bf16x8 vf = *(const bf16x8*)(sV + (dt * 16 + fr) * 128 + ((i * 4 + fq) ^ vswz) * 16);
                O[0][dt] = mfma16(vf, pf[0][i], O[0][dt]);
                O[1][dt] = mfma16(vf, pf[1][i], O[1][dt]);
            }
        }
        asm volatile("s_waitcnt vmcnt(0)" ::: "memory");
        __syncthreads();
        if (jn < 0) break;
        j = jn; cur ^= 1;
    }
#undef FL_ISSUE
#pragma unroll
    for (int qt = 0; qt < 2; ++qt) { lrow[qt] += __shfl_xor(lrow[qt], 16); lrow[qt] += __shfl_xor(lrow[qt], 32); }
}

__device__ __forceinline__ float sigmoidf_(float x) { return __builtin_amdgcn_rcpf(1.0f + __expf(-x)); }
__device__ __forceinline__ void nsa_tile(const Params& p, int qb, int bg, char* smem) {
    int tid = threadIdx.x; asm volatile("" : "+v"(tid));
    const int lane = tid & 63, w = tid >> 6, fr = lane & 15, fq = lane >> 4;
    const int b = bg >> 2, g = bg & 3, t0 = qb * 32, hq = g * 4 + w;
    const bf16_t* projA = (const bf16_t*)(p.ws + OFF_PROJA);
    const bf16_t* projVT = (const bf16_t*)(p.ws + OFF_PROJVT);
    float* part = (float*)(smem + 36864);
    u64* selmask = (u64*)(smem + 69632);
    bf16x8 qf[2][2];
    int tpos[2];
    float glog[2][3];
#define NSA_GATE(qt, br) sigmoidf_(glog[qt][br])
    const bf16_t* qbase = projA + (size_t)(b * S + t0) * LDA;
#pragma unroll
    for (int qt = 0; qt < 2; ++qt) {
        tpos[qt] = t0 + qt * 16 + fr;
        const bf16_t* qrow = qbase + (size_t)(qt * 16 + fr) * LDA;
#pragma unroll
        for (int ks = 0; ks < 2; ++ks) qf[qt][ks] = *(const bf16x8*)(qrow + hq * 64 + ks * 32 + fq * 8);
#pragma unroll
        for (int br = 0; br < 3; ++br) glog[qt][br] = __uint_as_float(((unsigned)qrow[2048 + hq * 3 + br]) << 16);
    }
    f32x4 outacc[2][4];
    {
        const bf16_t* kcg = (const bf16_t*)(p.ws + OFF_KC) + (size_t)bg * 256 * 64;
        const int nkp0 = (qb >> 4) + 1;
        for (int i = 0; i < nkp0; ++i) {
            const int q = w + 4 * i, row = q * 8 + (lane >> 3), cp = lane & 7;
            const int f = ((row >> 1) & 1) | (((row >> 3) & 1) << 1) | (((row >> 4) & 1) << 2);
            __builtin_amdgcn_global_load_lds((const unsigned*)(kcg + row * 64 + (cp ^ f) * 8), (__attribute__((address_space(3))) unsigned*)(smem + q * 1024), 16, 0, 0);
        }
        asm volatile("s_waitcnt vmcnt(0)" ::: "memory");
    }
    __syncthreads();
    {
        const bf16_t* vct = (const bf16_t*)(p.ws + OFF_VCT) + (size_t)bg * 64 * 256;
        const int nkp = (qb >> 4) + 1;
        float mc[2] = {-1e30f, -1e30f}, lc[2] = {0.f, 0.f};
#pragma unroll 2
        for (int i = 0; i < nkp; ++i) {
#pragma unroll
            for (int half = 0; half < 2; ++half) {
                const int kr = 32 * i + (fr >> 2) * 8 + half * 4 + (fr & 3);
                f32x4 s0 = zero4(), s1 = zero4();
#pragma unroll
                for (int ks = 0; ks < 2; ++ks) {
                    const bf16x8 kf = *(const bf16x8*)(smem + kr * 128 + ((ks * 4 + fq) ^ ((fr >> 1) & 7)) * 16);
                    s0 = mfma16(kf, qf[0][ks], s0);
                    s1 = mfma16(kf, qf[1][ks], s1);
                }
#pragma unroll
                for (int qt = 0; qt < 2; ++qt) {
                    const f32x4 sv = qt ? s1 : s0;
                    float mx = -1e30f; float vals[4];
#pragma unroll
                    for (int jj = 0; jj < 4; ++jj) {
                        const int nn = 32 * i + fq * 8 + half * 4 + jj;
                        vals[jj] = (16 * nn + 31 <= tpos[qt]) ? sv[jj] : -1e30f;
                        mx = fmaxf(mx, vals[jj]);
                    }
                    mx = fmaxf(mx, __shfl_xor(mx, 16));
                    mx = fmaxf(mx, __shfl_xor(mx, 32));
                    const float mnew = fmaxf(mc[qt], mx);
                    float ps = 0.f;
#pragma unroll
                    for (int jj = 0; jj < 4; ++jj) ps += __builtin_amdgcn_exp2f(vals[jj] - mnew);
                    ps += __shfl_xor(ps, 16);
                    ps += __shfl_xor(ps, 32);
                    lc[qt] = lc[qt] * __builtin_amdgcn_exp2f(mc[qt] - mnew) + ps;
                    mc[qt] = mnew;
                }
            }
        }
        const float il[2] = {1.0f / lc[0], 1.0f / lc[1]};
        f32x4 Oc[2][4];
#pragma unroll
        for (int qt = 0; qt < 2; ++qt)
#pragma unroll
            for (int dt = 0; dt < 4; ++dt) Oc[qt][dt] = zero4();
        float carry[2] = {0.f, 0.f};
#pragma unroll 2
        for (int i = 0; i < nkp; ++i) {
            f32x4 pr[2][2];
#pragma unroll
            for (int half = 0; half < 2; ++half) {
                const int kr = 32 * i + (fr >> 2) * 8 + half * 4 + (fr & 3);
                f32x4 s0 = zero4(), s1 = zero4();
#pragma unroll
                for (int ks = 0; ks < 2; ++ks) {
                    const bf16x8 kf = *(const bf16x8*)(smem + kr * 128 + ((ks * 4 + fq) ^ ((fr >> 1) & 7)) * 16);
                    s0 = mfma16(kf, qf[0][ks], s0);
                    s1 = mfma16(kf, qf[1][ks], s1);
                }
#pragma unroll
                for (int qt = 0; qt < 2; ++qt) {
                    const f32x4 sv = qt ? s1 : s0;
#pragma unroll
                    for (int jj = 0; jj < 4; ++jj) {
                        const int nn = 32 * i + fq * 8 + half * 4 + jj;
                        pr[qt][half][jj] = (16 * nn + 31 <= tpos[qt]) ? __builtin_amdgcn_exp2f(sv[jj] - mc[qt]) * il[qt] : 0.f;
                    }
                }
            }
            bf16x8 pfc[2];
#pragma unroll
            for (int qt = 0; qt < 2; ++qt) {
                const float a0 = (pr[qt][0][0] + pr[qt][0][1]) + (pr[qt][0][2] + pr[qt][0][3]);
                const float a1 = (pr[qt][1][0] + pr[qt][1][1]) + (pr[qt][1][2] + pr[qt][1][3]);
                const float e0 = pr[qt][0][3], e1 = pr[qt][1][3];
                const float up = __shfl(e1, (lane + 48) & 63);
                const float c0 = a0 + (fq == 0 ? carry[qt] : up);
                const float c1 = a1 + e0;
                carry[qt] = __shfl(e1, fr + 48);
                float* dst = part + ((w * 32 + qt * 16 + fr) * 64 + 8 * i + 2 * fq);
                *(float2*)dst = make_float2(c0, c1);
                u32x4 pk;
                pk.x = cvt_pk_bf16(pr[qt][0][0], pr[qt][0][1]); pk.y = cvt_pk_bf16(pr[qt][0][2], pr[qt][0][3]);
                pk.z = cvt_pk_bf16(pr[qt][1][0], pr[qt][1][1]); pk.w = cvt_pk_bf16(pr[qt][1][2], pr[qt][1][3]);
                pfc[qt] = __builtin_bit_cast(bf16x8, pk);
            }
#pragma unroll
            for (int dt = 0; dt < 4; ++dt) {
                const bf16x8 vf = *(const bf16x8*)(vct + ((size_t)(2 * i + (fq >> 1)) * 64 + dt * 16 + fr) * 16 + (fq & 1) * 8);
                Oc[0][dt] = mfma16(vf, pfc[0], Oc[0][dt]);
                Oc[1][dt] = mfma16(vf, pfc[1], Oc[1][dt]);
            }
        }
#pragma unroll
        for (int qt = 0; qt < 2; ++qt) {
            const float gq = NSA_GATE(qt, 0);
#pragma unroll
            for (int dt = 0; dt < 4; ++dt) outacc[qt][dt] = Oc[qt][dt] * gq;
        }
    }
    __syncthreads();
    {
        for (int tt = 0; tt < 8; ++tt) {
            const int tok = w * 8 + tt, t = t0 + tok, cur = t >> 6;
            float v = (part[(0 * 32 + tok) * 64 + lane] + part[(1 * 32 + tok) * 64 + lane]) + (part[(2 * 32 + tok) * 64 + lane] + part[(3 * 32 + tok) * 64 + lane]);
            v = (lane < 8 * ((qb >> 4) + 1)) ? v : 0.f;
            const bool forced = (lane == 0) || (lane == cur) || (lane == cur - 1);
            const bool future = lane > cur;
            v = forced ? 1e9f : (future ? -1e9f : v);
            int cnt = 0;
#pragma unroll
            for (int i = 0; i < 64; ++i) {
                const float vi = __uint_as_float(__builtin_amdgcn_readlane(__float_as_uint(v), i));
                cnt += ((vi > v) || (vi == v && i < lane)) ? 1 : 0;
            }
            const u64 mk = __ballot((cnt < 16) && !future);
            if (lane == 0) selmask[tok] = mk;
        }
    }
    __syncthreads();
    u64 ormask = 0;
#pragma unroll 4
    for (int i = 0; i < 32; ++i) ormask |= selmask[i];
    ormask = ((u64)__builtin_amdgcn_readfirstlane((unsigned)(ormask >> 32)) << 32) | (u64)__builtin_amdgcn_readfirstlane((unsigned)ormask);
    const u64 selm[2] = {~0ull, ~0ull};
    const int cur0 = t0 >> 6;
    float* park = part;
    __syncthreads();
#pragma unroll
    for (int qt = 0; qt < 2; ++qt)
#pragma unroll
        for (int dt = 0; dt < 4; ++dt)
            ((f32x4*)park)[(qt * 4 + dt) * 256 + tid] = outacc[qt][dt];
    {
        f32x4 O[2][4];
#pragma unroll
        for (int qt = 0; qt < 2; ++qt)
#pragma unroll
            for (int dt = 0; dt < 4; ++dt) O[qt][dt] = zero4();
        float mr[2] = {-1e30f, -1e30f}, lr[2] = {0.f, 0.f};
        const int lo[2] = {-1, -1};
        flash_branch<64, 64, true>(ormask, projA + (size_t)b * S * LDA + 1536 + g * 64, LDA, projVT + ((size_t)b * 512 + g * 64) * S, 0,
                                   qf, O, mr, lr, tpos, selm, lo, t0, -1, smem);
#pragma unroll
        for (int qt = 0; qt < 2; ++qt) {
            const float sc = NSA_GATE(qt, 1) / lr[qt];
#pragma unroll
            for (int dt = 0; dt < 4; ++dt) ((f32x4*)park)[(qt * 4 + dt) * 256 + tid] = ((f32x4*)park)[(qt * 4 + dt) * 256 + tid] + O[qt][dt] * sc;
        }
    }
    {
        f32x4 O[2][4];
#pragma unroll
        for (int qt = 0; qt < 2; ++qt)
#pragma unroll
            for (int dt = 0; dt < 4; ++dt) O[qt][dt] = zero4();
        float mr[2] = {-1e30f, -1e30f}, lr[2] = {0.f, 0.f};
        const int lo[2] = {tpos[0] - 512, tpos[1] - 512};
        const u64 ones[2] = {~0ull, ~0ull};
        int jlo = t0 - 511; jlo = jlo < 0 ? 0 : (jlo >> 6);
        const u64 upto = (cur0 == 63) ? ~0ull : ((1ull << (cur0 + 1)) - 1ull);
        const u64 tiles = upto & ~((1ull << jlo) - 1ull);
        flash_branch<64, 64, false>(tiles, projA + (size_t)b * S * LDA + 1792 + g * 64, LDA, projVT + ((size_t)b * 512 + 256 + g * 64) * S, 0,
                                    qf, O, mr, lr, tpos, ones, lo, t0, t0 + 31 - 512, smem);
#pragma unroll
        for (int qt = 0; qt < 2; ++qt) {
            const float sc = NSA_GATE(qt, 2) / lr[qt];
            bf16_t* ao = (bf16_t*)(p.ws + OFF_ATTN) + (size_t)(b * S + tpos[qt]) * D + hq * 64 + fq * 4;
#pragma unroll
            for (int dt = 0; dt < 4; ++dt) {
                const f32x4 r = ((f32x4*)park)[(qt * 4 + dt) * 256 + tid] + O[qt][dt] * sc;
                *(u32x2*)(ao + dt * 16) = pack4(r);
            }
        }
    }
    __syncthreads();
}

__device__ __forceinline__ void diff_tile(const Params& p, int qb, int bh, float lam, char* smem) {
    int tid = threadIdx.x; asm volatile("" : "+v"(tid));
    const int lane = tid & 63, w = tid >> 6, fr = lane & 15, fq = lane >> 4;
    const int b = bh >> 3, h = bh & 7, map = w >> 1, half = w & 1, tw0 = qb * 64 + half * 32;
    const bf16_t* projA = (const bf16_t*)(p.ws + OFF_PROJA);
    const bf16_t* projVT = (const bf16_t*)(p.ws + OFF_PROJVT);
    bf16x8 qf[2][2];
    int tpos[2];
#pragma unroll
    for (int qt = 0; qt < 2; ++qt) {
        tpos[qt] = tw0 + qt * 16 + fr;
        const bf16_t* qrow = projA + (size_t)(b * S + tpos[qt]) * LDA + (h * 2 + map) * 64;
#pragma unroll
        for (int ks = 0; ks < 2; ++ks) qf[qt][ks] = *(const bf16x8*)(qrow + ks * 32 + fq * 8);
    }
    f32x4 O[2][8];
#pragma unroll
    for (int qt = 0; qt < 2; ++qt)
#pragma unroll
        for (int dt = 0; dt < 8; ++dt) O[qt][dt] = zero4();
    float mr[2] = {-1e30f, -1e30f}, lr[2] = {0.f, 0.f};
    const int lo[2] = {-1, -1};
    const u64 ones[2] = {~0ull, ~0ull};
    const u64 tiles = (qb == 63) ? ~0ull : ((1ull << (qb + 1)) - 1ull);
    flash_branch<128, 128, false>(tiles, projA + (size_t)b * S * LDA + 1024 + h * 128, LDA, projVT + ((size_t)b * 1024 + h * 128) * S, map * 64,
                                  qf, O, mr, lr, tpos, ones, lo, qb * 64, -1, smem);
    float* xch = (float*)smem;
    const float il[2] = {__builtin_amdgcn_rcpf(lr[0]), __builtin_amdgcn_rcpf(lr[1])};
    if (map == 1) {
#pragma unroll
        for (int qt = 0; qt < 2; ++qt)
#pragma unroll
            for (int dt = 0; dt < 8; ++dt) *(f32x4*)(xch + (half * 32 + qt * 16 + fr) * 132 + dt * 16 + fq * 4) = O[qt][dt] * il[qt];
    }
    __syncthreads();
    if (map == 0) {
        const float* sg = p.in[16];
        bf16_t* ao = (bf16_t*)(p.ws + OFF_ATTN);
#pragma unroll
        for (int qt = 0; qt < 2; ++qt) {
            float ss = 0.f;
#pragma unroll
            for (int dt = 0; dt < 8; ++dt) {
                const f32x4 o2 = *(const f32x4*)(xch + (half * 32 + qt * 16 + fr) * 132 + dt * 16 + fq * 4);
#pragma unroll
                for (int j = 0; j < 4; ++j) {
                    const float o = O[qt][dt][j] * il[qt] - lam * o2[j];
                    O[qt][dt][j] = o; ss += o * o;
                }
            }
            ss += __shfl_xor(ss, 16);
            ss += __shfl_xor(ss, 32);
            const float r = rsqrtf(ss * (1.0f / 128.0f) + EPS) * (1.0f - LAMBDA_INIT);
#pragma unroll
            for (int dt = 0; dt < 8; ++dt) {
                const f32x4 gv = *(const f32x4*)(sg + dt * 16 + fq * 4);
                *(u32x2*)(ao + (size_t)(b * S + tpos[qt]) * D + h * 128 + dt * 16 + fq * 4) = pack4(O[qt][dt] * r * gv);
            }
        }
    }
    __syncthreads();
}

constexpr size_t OFF_BAR = 52 * MiB + 512 * 1024;
#define XB_TMO      128
#define XB_XCNT(j)  (256  + 64 * (j))
#define XB_XSUB(j)  (1280 + 64 * (j))
#define XB_XGEN(j)  (2304 + 64 * (j))
#define XB_TOP      3328
#define XB_TOPGEN   3392
#define XCD_BAR_WORDS 3456
#define XB_SPIN_CAP (1u << 23)
#define LAS __attribute__((address_space(3)))
__device__ __forceinline__ unsigned xb_ld(unsigned* p)              { return __hip_atomic_load(p, __ATOMIC_RELAXED, __HIP_MEMORY_SCOPE_AGENT); }
__device__ __forceinline__ unsigned xb_add(unsigned* p, unsigned v) { return __hip_atomic_fetch_add(p, v, __ATOMIC_RELAXED, __HIP_MEMORY_SCOPE_AGENT); }
__device__ __forceinline__ unsigned xb_xcc_id() { return (unsigned)__builtin_amdgcn_s_getreg((3 << 11) | 20) & 0xFu; }
#define XB_SPIN(cond, bar) do { unsigned _sp = 0; while (cond) { __builtin_amdgcn_s_sleep(1); \
    if ((++_sp & 255u) == 0u) { if (xb_ld(&(bar)[XB_TMO])) break; if (_sp > XB_SPIN_CAP) { atomicAdd(&(bar)[XB_TMO], 1u); break; } } } } while (0)
struct XcdBarrier { unsigned* bar; unsigned x; volatile LAS unsigned* st; };
__device__ __forceinline__ XcdBarrier xcd_barrier_post(unsigned* bar, volatile LAS unsigned* st) {
    XcdBarrier b; b.bar = bar; b.x = xb_xcc_id(); b.st = st;
    if (threadIdx.x == 0) (void)xb_add(&bar[XB_XCNT(b.x)], 1u);
    return b;
}
__device__ __forceinline__ void xcd_barrier_complete(unsigned* bar, unsigned x, unsigned& nloc, unsigned& nx) {
    const unsigned G = gridDim.x * gridDim.y * gridDim.z;
    unsigned sum, cnt, mine, sp = 0u;
    for (;;) {
        sum = 0u; cnt = 0u; mine = 0u;
#pragma unroll
        for (unsigned j = 0; j < 16; ++j) { const unsigned c = xb_ld(&bar[XB_XCNT(j)]); sum += c; cnt += (c > 0u) ? 1u : 0u; mine = (j == x) ? c : mine; }
        if (sum == G) break;
        __builtin_amdgcn_s_sleep(1);
        if ((++sp & 255u) == 0u) { if (xb_ld(&bar[XB_TMO])) break; if (sp > XB_SPIN_CAP) { atomicAdd(&bar[XB_TMO], 1u); break; } }
    }
    nloc = mine > 0u ? mine : 1u; nx = cnt > 0u ? cnt : 1u;
}
__device__ __forceinline__ void gsync(const XcdBarrier& b) {
    asm volatile("s_waitcnt vmcnt(0) lgkmcnt(0)" ::: "memory");
    __syncthreads();
    if (threadIdx.x == 0) {
        unsigned* bar = b.bar; unsigned bx = b.x;
        asm volatile("" : "+s"(bar), "+s"(bx));
        __builtin_amdgcn_s_waitcnt(0);
        unsigned nloc = b.st[0], nx = b.st[1];
        if (nloc == 0u) { xcd_barrier_complete(bar, bx, nloc, nx); b.st[0] = nloc; b.st[1] = nx; }
        const unsigned old = xb_add(&bar[XB_XSUB(bx)], 1u);
        const unsigned gen = old / nloc;
        if (old + 1u == (gen + 1u) * nloc) {
            __builtin_amdgcn_fence(__ATOMIC_RELEASE, "agent");
            asm volatile("s_waitcnt vmcnt(0)" ::: "memory");
            const unsigned og = xb_add(&bar[XB_TOP], 1u);
            const unsigned tg = og / nx;
            if (og + 1u == (tg + 1u) * nx) xb_add(&bar[XB_TOPGEN], 1u);
            else XB_SPIN(xb_ld(&bar[XB_TOPGEN]) == tg, bar);
            __builtin_amdgcn_fence(__ATOMIC_ACQUIRE, "agent");
            xb_add(&bar[XB_XGEN(bx)], 1u);
            asm volatile("s_waitcnt vmcnt(0)" ::: "memory");
        } else {
            XB_SPIN(xb_ld(&bar[XB_XGEN(bx)]) == gen, bar);
            __builtin_amdgcn_fence(__ATOMIC_ACQUIRE, "agent");
            asm volatile("s_waitcnt vmcnt(0)" ::: "memory");
        }
    }
    __syncthreads();
}
__global__ void __launch_bounds__(256, 2) fwd_megakernel(Params p) {
    __shared__ __attribute__((aligned(16))) char smem[SMEM_BYTES];
    __shared__ uint4 xb_words;
    cg::grid_group grid = cg::this_grid();
    if (p.ws == nullptr) grid.sync();
    if (threadIdx.x == 0) xb_words = make_uint4(0u, 0u, 0u, 0u);
    __syncthreads();
    const XcdBarrier xb = xcd_barrier_post((unsigned*)(p.ws + OFF_BAR), (volatile LAS unsigned*)&xb_words);
    bf16_t* WT = (bf16_t*)(p.ws + OFF_WT);
    const float* rope = (const float*)(p.ws + OFF_ROPE);
    bf16_t* xn = (bf16_t*)(p.ws + OFF_XN);
    bf16_t* projA = (bf16_t*)(p.ws + OFF_PROJA);
    bf16_t* projVT = (bf16_t*)(p.ws + OFF_PROJVT);
    bf16_t* attn = (bf16_t*)(p.ws + OFF_ATTN);
    bf16_t* hid = (bf16_t*)(p.ws + OFF_HID);
    const int G = gridDim.x;

    prologue_phase(p, smem);
    rmsnorm_phase(p.in[0], p.in[1], xn, nullptr);
    gsync(xb);
    {
        EpiProj e1{projA, LDA, 1536, rope};
        EpiVT e2{projVT, 512};
        gemm_phase2(xn, WT + WT_NSA_IN, T, 2176, e1, WT + WT_NSA_IN + (size_t)2176 * 1024, xn, 512, T, e2, 1024, smem);
    }
    gsync(xb);
    for (int task = blockIdx.x; task < 1024; task += G) compress_task(p, task, smem);
    gsync(xb);
    for (int r = 0; r * G < 4096; ++r) {
        const int k = (r & 1) ? (G - 1 - (int)blockIdx.x) : (int)blockIdx.x, i = r * G + k;
        if (i < 4096) nsa_tile(p, 127 - (i >> 5), i & 31, smem);
    }
    gsync(xb);
    { EpiResid e{p.in[0], p.out}; gemm_phase(attn, WT + WT_NSA_OUT, T, 1024, 1024, e, smem); }
    gsync(xb);
    rmsnorm_phase(p.out, p.in[2], xn, nullptr);
    gsync(xb);
    { EpiSqRelu e{hid}; gemm_phase(xn, WT + WT_UP0, T, FF, 1024, e, smem); }
    gsync(xb);
    { EpiResid e{p.out, p.out}; gemm_phase(hid, WT + WT_DN0, T, 1024, FF, e, smem); }
    gsync(xb);
    rmsnorm_phase(p.out, p.in[1] + D, xn, nullptr);
    gsync(xb);
    {
        EpiProj e1{projA, LDA, 1024, rope};
        EpiVT e2{projVT, 1024};
        gemm_phase2(xn, WT + WT_DIFF_IN, T, 2048, e1, WT + WT_DIFF_IN + (size_t)2048 * 1024, xn, 1024, T, e2, 1024, smem);
    }
    gsync(xb);
    {
        const int lane = threadIdx.x & 63;
        float a = p.in[12][lane] * p.in[13][lane], c = p.in[14][lane] * p.in[15][lane];
#pragma unroll
        for (int o = 32; o >= 1; o >>= 1) { a += __shfl_xor(a, o); c += __shfl_xor(c, o); }
        const float lam = expf(a) - expf(c) + LAMBDA_INIT;
        for (int r = 0; r * G < 4096; ++r) {
            const int k = (r & 1) ? (G - 1 - (int)blockIdx.x) : (int)blockIdx.x, i = r * G + k;
            if (i < 4096) diff_tile(p, 63 - (i >> 6), i & 63, lam, smem);
        }
    }
    gsync(xb);
    { EpiResid e{p.out, p.out}; gemm_phase(attn, WT + WT_DIFF_OUT, T, 1024, 1024, e, smem); }
    gsync(xb);
    rmsnorm_phase(p.out, p.in[2] + D, xn, nullptr);
    gsync(xb);
    { EpiSqRelu e{hid}; gemm_phase(xn, WT + WT_UP1, T, FF, 1024, e, smem); }
    gsync(xb);
    { EpiResid e{p.out, p.out}; gemm_phase(hid, WT + WT_DN1, T, 1024, FF, e, smem); }
    gsync(xb);
    rmsnorm_phase(p.out, p.in[20], nullptr, p.out);
}

extern "C" void kernel_launch(void* const* d_in, const int* in_sizes, int n_in, void* d_out, int out_size, void* d_ws, size_t ws_size, hipStream_t stream) {
    static int grid_blocks = 0;
    if (!grid_blocks) {
        int dev = 0, cus = 0, per_cu = 0;
        hipGetDevice(&dev);
        hipDeviceGetAttribute(&cus, hipDeviceAttributeMultiprocessorCount, dev);
        hipOccupancyMaxActiveBlocksPerMultiprocessor(&per_cu, fwd_megakernel, 256, 0);
        if (per_cu > 2) per_cu = 2;
        grid_blocks = cus * per_cu;
    }
    if (ws_size < WS_NEED) { fprintf(stderr, "workspace too small: %zu < %zu\n", ws_size, (size_t)WS_NEED); return; }
    Params p{};
    for (int i = 0; i < 21; ++i) p.in[i] = (const float*)d_in[i];
    p.out = (float*)d_out;
    p.ws = (char*)d_ws;
    hipMemsetAsync((char*)d_ws + OFF_BAR, 0, XCD_BAR_WORDS * 4, stream);
    void* args[] = {&p};
    hipError_t e = hipLaunchCooperativeKernel((void*)fwd_megakernel, dim3(grid_blocks), dim3(256), args, 0, stream);
    if (e != hipSuccess) fprintf(stderr, "cooperative launch failed: %s (grid %d)\n", hipGetErrorString(e), grid_blocks);
}
```

```cpp
#include <hip/hip_runtime.h>
#include <hip/hip_cooperative_groups.h>
#include <stdint.h>
#include <cstdio>
namespace cg = cooperative_groups;

typedef unsigned short bf16_t;
typedef short bf16x8 __attribute__((ext_vector_type(8)));
typedef float f32x4 __attribute__((ext_vector_type(4)));
typedef unsigned u32x4 __attribute__((ext_vector_type(4)));
typedef unsigned u32x2 __attribute__((ext_vector_type(2)));
typedef unsigned long long u64;

constexpr int NB = 8, S = 4096, D = 1024, T = NB * S, FF = 4096;
constexpr int LDA = 2176;
constexpr float EPS = 1e-6f;
constexpr float LAMBDA_INIT = 0.35550906759096934f;
constexpr int SMEM_BYTES = 73728;

constexpr size_t MiB = 1048576;
constexpr size_t OFF_WT = 0, OFF_ROPE = 52 * MiB, OFF_KC = 53 * MiB, OFF_VCT = 54 * MiB, OFF_XN = 56 * MiB,
                 OFF_PROJA = 120 * MiB, OFF_PROJVT = 256 * MiB, OFF_ATTN = 320 * MiB, OFF_HID = 120 * MiB, WS_NEED = 384 * MiB;
constexpr size_t WT_NSA_IN = 0, WT_NSA_OUT = 2752512, WT_DIFF_IN = 3801088, WT_DIFF_OUT = 6946816, WT_UP0 = 7995392, WT_UP1 = 12189696,
                 WT_DN0 = 16384000, WT_DN1 = 20578304, WT_CKW1 = 24772608, WT_CVW1 = 25296896, WT_CKW2 = 25821184, WT_CVW2 = 25837568;

struct Params {
    const float* in[21];
    float* out;
    char* ws;
};

typedef __bf16 bf16x2_t __attribute__((ext_vector_type(2)));
typedef float f32x2_t __attribute__((ext_vector_type(2)));
__device__ __forceinline__ unsigned cvt_pk_bf16(float lo, float hi) { const f32x2_t f = {lo, hi}; return __builtin_bit_cast(unsigned, __builtin_convertvector(f, bf16x2_t)); }
__device__ __forceinline__ float bf_lo(unsigned u) { return __uint_as_float(u << 16); }
__device__ __forceinline__ float bf_hi(unsigned u) { return __uint_as_float(u & 0xffff0000u); }
__device__ __forceinline__ u32x2 pack4(f32x4 v) { u32x2 r; r.x = cvt_pk_bf16(v[0], v[1]); r.y = cvt_pk_bf16(v[2], v[3]); return r; }
__device__ __forceinline__ f32x4 mfma16(bf16x8 a, bf16x8 b, f32x4 c) { return __builtin_amdgcn_mfma_f32_16x16x32_bf16(a, b, c, 0, 0, 0); }
__device__ __forceinline__ f32x4 zero4() { return (f32x4){0.f, 0.f, 0.f, 0.f}; }

__device__ __forceinline__ int lds_byte(int r, int c) {
    const int st = (r >> 4) * 2 + (c >> 5), ob = (r & 15) * 64 + (c & 31) * 2;
    return st * 1024 + (ob ^ (((ob >> 9) & 1) << 5));
}
__device__ __forceinline__ void stage_rc(int b, int& R, int& C) {
    const int st = b >> 10, sb = b & 1023, swz = sb ^ (((sb >> 9) & 1) << 5);
    R = (st >> 1) * 16 + swz / 64;
    C = (st & 1) * 32 + (swz % 64) / 2;
}
constexpr int TILE_B = 128 * 64 * 2;
template <class Epi>
__device__ __forceinline__ void gemm_tile(const bf16_t* __restrict__ A, const bf16_t* __restrict__ Bt, int K, int row0, int col0, const Epi& epi, char* smem,
                                          bool prefetched, bool nvalid, int nrow0, int ncol0) {
    const int tid = threadIdx.x, lane = tid & 63, w = tid >> 6, wr = w >> 1, wc = w & 1, fr = lane & 15, fq = lane >> 4;
    f32x4 acc[4][4];
#pragma unroll
    for (int m = 0; m < 4; ++m)
#pragma unroll
        for (int n = 0; n < 4; ++n) acc[m][n] = zero4();
    int soffA[4], soffB[4];
#pragma unroll
    for (int i = 0; i < 4; ++i) {
        const int row = (w + 4 * i) * 8 + (lane >> 3), cp = lane & 7;
        soffA[i] = row * K + (cp ^ ((row >> 1) & 7)) * 8;
        soffB[i] = row * K + (cp ^ (((row >> 1) & 1) | (((row >> 3) & 1) << 1) | (((row >> 4) & 1) << 2))) * 8;
    }
    const bf16_t* pA = A + (size_t)row0 * K;
    const bf16_t* pB = Bt + (size_t)col0 * K;
#define GLDS_STAGE(buf, PA, PB, kt) do { _Pragma("unroll") for (int i = 0; i < 4; ++i) { \
        __builtin_amdgcn_global_load_lds((const unsigned*)((PA) + soffA[i] + (kt) * 64), (__attribute__((address_space(3))) unsigned*)(smem + (buf) * 2 * TILE_B + w * 1024 + i * 4096), 16, 0, 0); \
        __builtin_amdgcn_global_load_lds((const unsigned*)((PB) + soffB[i] + (kt) * 64), (__attribute__((address_space(3))) unsigned*)(smem + (buf) * 2 * TILE_B + TILE_B + w * 1024 + i * 4096), 16, 0, 0); } } while (0)
    int offA[4][2], offB[4][2];
#pragma unroll
    for (int m = 0; m < 4; ++m)
#pragma unroll
        for (int ks = 0; ks < 2; ++ks) { const int cx = ((ks * 4 + fq) ^ ((fr >> 1) & 7)) * 16;
            offA[m][ks] = (wr * 64 + m * 16 + fr) * 128 + cx;
            offB[m][ks] = TILE_B + (wc * 64 + (m >> 1) * 32 + 8 * (fr >> 2) + 4 * (m & 1) + (fr & 3)) * 128 + cx; }
    if (prefetched) {
        if (Epi::STAGED) asm volatile("s_waitcnt vmcnt(8)" ::: "memory");
        else asm volatile("s_waitcnt vmcnt(0)" ::: "memory");
    } else {
        GLDS_STAGE(0, pA, pB, 0);
        asm volatile("s_waitcnt vmcnt(0)" ::: "memory");
    }
    __syncthreads();
    const int nk = K >> 6;
    for (int kt = 0; kt < nk; ++kt) {
        const int cur = kt & 1;
        if (kt + 1 < nk) GLDS_STAGE(cur ^ 1, pA, pB, kt + 1);
        const char* cb = smem + cur * 2 * TILE_B;
#pragma unroll
        for (int ks = 0; ks < 2; ++ks) {
            bf16x8 a[4], b[4];
#pragma unroll
            for (int m = 0; m < 4; ++m) a[m] = *(const bf16x8*)(cb + offA[m][ks]);
#pragma unroll
            for (int n = 0; n < 4; ++n) b[n] = *(const bf16x8*)(cb + offB[n][ks]);
#pragma unroll
            for (int m = 0; m < 4; ++m)
#pragma unroll
                for (int n = 0; n < 4; ++n) acc[m][n] = mfma16(b[n], a[m], acc[m][n]);
        }
        asm volatile("s_waitcnt vmcnt(0)" ::: "memory");
        __syncthreads();
    }
    if (nvalid) { const bf16_t* qA = A + (size_t)nrow0 * K; const bf16_t* qB = Bt + (size_t)ncol0 * K; GLDS_STAGE(0, qA, qB, 0); }
#undef GLDS_STAGE
    if constexpr (Epi::STAGED) {
        bf16_t* st = (bf16_t*)(smem + 2 * TILE_B);
        epi.to_lds(acc, st, row0, col0, wr, wc, fr, fq);
        __syncthreads();
        bf16_t* gbase; size_t gstride;
        epi.dest(row0, col0, gbase, gstride);
        const int r0 = tid >> 4, ch = (tid & 15) * 8;
#pragma unroll
        for (int it = 0; it < 8; ++it) { const int r = it * 16 + r0; __builtin_nontemporal_store(*(const u32x4*)(st + r * 136 + ch), (u32x4*)(gbase + (size_t)r * gstride + ch)); }
    } else {
        epi(acc, row0 + wr * 64, col0 + wc * 64, fr, fq);
    }
    if (!nvalid) { asm volatile("s_waitcnt vmcnt(0) lgkmcnt(0)" ::: "memory"); __syncthreads(); }
}

__device__ __forceinline__ u32x4 pack8(f32x4 a, f32x4 b) { u32x4 r; r.x = cvt_pk_bf16(a[0], a[1]); r.y = cvt_pk_bf16(a[2], a[3]); r.z = cvt_pk_bf16(b[0], b[1]); r.w = cvt_pk_bf16(b[2], b[3]); return r; }
struct EpiProj {
    static constexpr bool STAGED = true;
    bf16_t* out; int ld; int rope_lo2; const float* rope;
    __device__ __forceinline__ void dest(int row0, int col0, bf16_t*& g, size_t& stride) const { g = out + (size_t)row0 * ld + col0; stride = (size_t)ld; }
    __device__ __forceinline__ void to_lds(f32x4 (&acc)[4][4], bf16_t* st, int row0, int col0, int wr, int wc, int fr, int fq) const {
        const int cb = col0 + wc * 64;
        const bool isq = cb < 1024;
        const bool dorope = (cb < 1024) || (cb >= rope_lo2 && cb < 2048);
#pragma unroll
        for (int m = 0; m < 4; ++m) {
            const int rl = wr * 64 + m * 16 + fr;
            const int s = (row0 + rl) & (S - 1);
#pragma unroll
            for (int pp = 0; pp < 2; ++pp) {
                f32x4 v0 = acc[m][2 * pp], v1 = acc[m][2 * pp + 1];
                if (pp == 0 && dorope) {
                    f32x4 p0, p1;
#pragma unroll
                    for (int j = 0; j < 4; ++j) { p0[j] = __shfl_xor(v0[j], 16); p1[j] = __shfl_xor(v1[j], 16); }
                    const float* rp = rope + s * 16;
                    const f32x4 c0 = *(const f32x4*)rp, c1 = *(const f32x4*)(rp + 4), s0 = *(const f32x4*)(rp + 8), s1 = *(const f32x4*)(rp + 12);
                    if (fq == 0) { v0 = v0 * c0 - p0 * s0; v1 = v1 * c1 - p1 * s1; }
                    else if (fq == 1) { v0 = v0 * c0 + p0 * s0; v1 = v1 * c1 + p1 * s1; }
                }
                if (isq) { v0 = v0 * 0.18033688011112042f; v1 = v1 * 0.18033688011112042f; }
                *(u32x4*)(st + rl * 136 + wc * 64 + pp * 32 + 8 * fq) = pack8(v0, v1);
            }
        }
    }
};
struct EpiVT {
    static constexpr bool STAGED = true;
    bf16_t* out; int MV;
    __device__ __forceinline__ void dest(int row0, int col0, bf16_t*& g, size_t& stride) const { g = out + ((size_t)(col0 >> 12) * MV + row0) * S + (col0 & (S - 1)); stride = (size_t)S; }
    __device__ __forceinline__ void to_lds(f32x4 (&acc)[4][4], bf16_t* st, int row0, int col0, int wr, int wc, int fr, int fq) const {
#pragma unroll
        for (int m = 0; m < 4; ++m)
#pragma unroll
            for (int pp = 0; pp < 2; ++pp)
                *(u32x4*)(st + (wr * 64 + m * 16 + fr) * 136 + wc * 64 + pp * 32 + 8 * fq) = pack8(acc[m][2 * pp], acc[m][2 * pp + 1]);
    }
};
struct EpiResid {
    static constexpr bool STAGED = false;
    const float* res; float* out;
    __device__ __forceinline__ void operator()(f32x4 (&acc)[4][4], int rb, int cb, int fr, int fq) const {
        f32x4 r[4][2][2];
#pragma unroll
        for (int m = 0; m < 4; ++m)
#pragma unroll
            for (int pp = 0; pp < 2; ++pp) {
                const size_t o = (size_t)(rb + m * 16 + fr) * D + cb + pp * 32 + 8 * fq;
                r[m][pp][0] = __builtin_nontemporal_load((const f32x4*)(res + o));
                r[m][pp][1] = __builtin_nontemporal_load((const f32x4*)(res + o + 4));
            }
#pragma unroll
        for (int m = 0; m < 4; ++m)
#pragma unroll
            for (int pp = 0; pp < 2; ++pp) {
                const size_t o = (size_t)(rb + m * 16 + fr) * D + cb + pp * 32 + 8 * fq;
                *(f32x4*)(out + o) = r[m][pp][0] + acc[m][2 * pp];
                *(f32x4*)(out + o + 4) = r[m][pp][1] + acc[m][2 * pp + 1];
            }
    }
};
struct EpiSqRelu {
    static constexpr bool STAGED = true;
    bf16_t* out;
    __device__ __forceinline__ void dest(int row0, int col0, bf16_t*& g, size_t& stride) const { g = out + (size_t)row0 * FF + col0; stride = (size_t)FF; }
    __device__ __forceinline__ void to_lds(f32x4 (&acc)[4][4], bf16_t* st, int row0, int col0, int wr, int wc, int fr, int fq) const {
#pragma unroll
        for (int m = 0; m < 4; ++m)
#pragma unroll
            for (int pp = 0; pp < 2; ++pp) {
                f32x4 v0 = acc[m][2 * pp], v1 = acc[m][2 * pp + 1];
#pragma unroll
                for (int j = 0; j < 4; ++j) { const float u0 = fmaxf(v0[j], 0.f), u1 = fmaxf(v1[j], 0.f); v0[j] = u0 * u0; v1[j] = u1 * u1; }
                *(u32x4*)(st + (wr * 64 + m * 16 + fr) * 136 + wc * 64 + pp * 32 + 8 * fq) = pack8(v0, v1);
            }
    }
};

template <class Epi>
__device__ __forceinline__ void gemm_phase(const bf16_t* A, const bf16_t* Bt, int M, int N, int K, const Epi& epi, char* smem) {
    const int nN = N >> 7, ntiles = (M >> 7) * nN, G = gridDim.x;
    bool pre = false;
    for (int i = blockIdx.x; i < ntiles; i += G) {
        const int j = i + G; const bool nv = j < ntiles;
        gemm_tile(A, Bt, K, (i / nN) << 7, (i % nN) << 7, epi, smem, pre, nv, (j / nN) << 7, (j % nN) << 7);
        pre = nv;
    }
}
template <class E1, class E2>
__device__ __forceinline__ void gemm_phase2(const bf16_t* A1, const bf16_t* B1, int M1, int N1, const E1& e1,
                                            const bf16_t* A2, const bf16_t* B2, int M2, int N2, const E2& e2, int K, char* smem) {
    gemm_phase(A1, B1, M1, N1, K, e1, smem);
    const int nM2 = M2 >> 7, nt2 = nM2 * (N2 >> 7), G = gridDim.x;
    bool pre = false;
    for (int i = (blockIdx.x + (G >> 1)) % G; i < nt2; i += G) {
        const int j = i + G; const bool nv = j < nt2;
        gemm_tile(A2, B2, K, (i % nM2) << 7, (i / nM2) << 7, e2, smem, pre, nv, (j % nM2) << 7, (j / nM2) << 7);
        pre = nv;
    }
}

__device__ __forceinline__ void rmsnorm_phase(const float* x, const float* g, bf16_t* outb, float* outf) {
    const int lane = threadIdx.x & 63;
    const int gw = blockIdx.x * 4 + (threadIdx.x >> 6), nw = gridDim.x * 4;
    f32x4 gv[4];
#pragma unroll
    for (int i = 0; i < 4; ++i) gv[i] = *(const f32x4*)(g + (lane + i * 64) * 4);
    for (int row = gw; row < T; row += nw) {
        const float* xr = x + (size_t)row * D;
        f32x4 v[4];
        float ss = 0.f;
#pragma unroll
        for (int i = 0; i < 4; ++i) { v[i] = __builtin_nontemporal_load((const f32x4*)(xr + (lane + i * 64) * 4)); ss += v[i][0] * v[i][0] + v[i][1] * v[i][1] + v[i][2] * v[i][2] + v[i][3] * v[i][3]; }
#pragma unroll
        for (int o = 32; o >= 1; o >>= 1) ss += __shfl_xor(ss, o);
        const float r = rsqrtf(ss * (1.0f / D) + EPS);
#pragma unroll
        for (int i = 0; i < 4; ++i) {
            const f32x4 y = v[i] * r * gv[i];
            if (outb) *(u32x2*)(outb + (size_t)row * D + (lane + i * 64) * 4) = pack4(y);
            else __builtin_nontemporal_store(y, (f32x4*)(outf + (size_t)row * D + (lane + i * 64) * 4));
        }
    }
}

__device__ __forceinline__ int nsa_in_rowmap(int n) {
    if (n < 1792) return n;
    if (n < 2048) return 2176 + (n - 1792);
    if (n < 2304) return 1792 + (n - 2048);
    if (n < 2560) return 2176 + 256 + (n - 2304);
    return 2048 + (n - 2560);
}
__device__ __forceinline__ void tr_tile(const float* __restrict__ src, int K, int N, bf16_t* __restrict__ dst, bool remap, int kt, int nt, float* sm) {
    const int tid = threadIdx.x;
    const int r = tid >> 4, c4 = (tid & 15) * 4;
#pragma unroll
    for (int i = 0; i < 4; ++i) {
        const int k = kt * 64 + r + i * 16, n = nt * 64 + c4;
        f32x4 v = zero4();
        if (n < N) v = __builtin_nontemporal_load((const f32x4*)(src + (size_t)k * N + n));
        float* d = sm + (r + i * 16) * 65 + c4;
        d[0] = v[0]; d[1] = v[1]; d[2] = v[2]; d[3] = v[3];
    }
    __syncthreads();
    const int nl = tid >> 2, kc = (tid & 3) * 16, n = nt * 64 + nl;
    if (n < N) {
        const int rr = remap ? nsa_in_rowmap(n) : n;
        unsigned pk[8];
#pragma unroll
        for (int i = 0; i < 8; ++i) pk[i] = cvt_pk_bf16(sm[(kc + 2 * i) * 65 + nl], sm[(kc + 2 * i + 1) * 65 + nl]);
        bf16_t* dp = dst + (size_t)rr * K + kt * 64 + kc;
        *(u32x4*)dp = (u32x4){pk[0], pk[1], pk[2], pk[3]};
        *(u32x4*)(dp + 8) = (u32x4){pk[4], pk[5], pk[6], pk[7]};
    }
    __syncthreads();
}
__device__ __forceinline__ void prologue_phase(const Params& p, char* smem) {
    bf16_t* WT = (bf16_t*)(p.ws + OFF_WT);
    float* sm = (float*)smem;
    constexpr int NJ = 12;
    constexpr int NTR = 656 + 256 + 768 + 256 + 4096 + 256 + 8;
    const int ntask = NTR + 16;
    for (int task = blockIdx.x; task < ntask; task += gridDim.x) {
        if (task < NTR) {
            int t = task; const float* src; int K, N; bf16_t* dst; bool remap = false;
            if (t < 656) { src = p.in[3]; K = 1024; N = 2608; dst = WT + WT_NSA_IN; remap = true; }
            else if ((t -= 656) < 256) { src = p.in[10]; K = 1024; N = 1024; dst = WT + WT_NSA_OUT; }
            else if ((t -= 256) < 768) { src = p.in[11]; K = 1024; N = 3072; dst = WT + WT_DIFF_IN; }
            else if ((t -= 768) < 256) { src = p.in[17]; K = 1024; N = 1024; dst = WT + WT_DIFF_OUT; }
            else if ((t -= 256) < 1024) { src = p.in[18]; K = 1024; N = 4096; dst = WT + WT_UP0; }
            else if ((t -= 1024) < 1024) { src = p.in[18] + (size_t)1024 * 4096; K = 1024; N = 4096; dst = WT + WT_UP1; }
            else if ((t -= 1024) < 1024) { src = p.in[19]; K = 4096; N = 1024; dst = WT + WT_DN0; }
            else if ((t -= 1024) < 1024) { src = p.in[19] + (size_t)4096 * 1024; K = 4096; N = 1024; dst = WT + WT_DN1; }
            else if ((t -= 1024) < 128) { src = p.in[5]; K = 2048; N = 256; dst = WT + WT_CKW1; }
            else if ((t -= 128) < 128) { src = p.in[8]; K = 2048; N = 256; dst = WT + WT_CVW1; }
            else if ((t -= 128) < 4) { src = p.in[6]; K = 256; N = 64; dst = WT + WT_CKW2; }
            else { t -= 4; src = p.in[9]; K = 256; N = 64; dst = WT + WT_CVW2; }
            const int nkt = K >> 6;
            tr_tile(src, K, N, dst, remap, t % nkt, t / nkt, sm);
        } else {
            const int mt = task - NTR;
            float* rope = (float*)(p.ws + OFF_ROPE);
            const float invf[8] = {1.0f, 0.193922758102417f, 0.03760603070259094f, 0.00729266507551074f, 0.001414213445968926f,
                                   0.00027424818836152554f, 5.318296462064609e-05f, 1.0313385246263351e-05f};
            const int pos = mt * 256 + threadIdx.x;
#pragma unroll
            for (int i = 0; i < 8; ++i) {
                const float a = (float)pos * invf[i];
                const double ad = (double)a;
                const double kq = rint(ad * 0.15915494309189535);
                const float rr = (float)(ad - kq * 6.283185307179586);
                rope[pos * 16 + i] = __cosf(rr);
                rope[pos * 16 + 8 + i] = __sinf(rr);
            }
            u32x4* z = (u32x4*)(WT + WT_NSA_IN + (size_t)2096 * 1024);
            for (int i = mt * 256 + threadIdx.x; i < 10240; i += 16 * 256) z[i] = (u32x4){0u, 0u, 0u, 0u};
        }
    }
    (void)NJ;
}

__device__ __forceinline__ float gelu_tanh(float x) {
    const float u = 0.7978845608028654f * (x + 0.044715f * x * x * x);
    const float e = __expf(2.0f * u);
    const float th = 1.0f - 2.0f * __builtin_amdgcn_rcpf(e + 1.0f);
    return 0.5f * x * (1.0f + th);
}
__device__ __forceinline__ void compress_task(const Params& p, int task, char* smem) {
    const int tid = threadIdx.x, lane = tid & 63, w = tid >> 6, fr = lane & 15, fq = lane >> 4;
    const int kv = task >> 9, bg = (task >> 4) & 31, n0 = (task & 15) * 16;
    const int b = bg >> 2, g = bg & 3;
    const bf16_t* WT = (const bf16_t*)(p.ws + OFF_WT);
    const bf16_t* src = (const bf16_t*)(p.ws + OFF_PROJA) + (size_t)b * S * LDA + 1024 + kv * 256 + g * 64;
    const float* pos = kv ? p.in[7] : p.in[4];
    const bf16_t* w1t = WT + (kv ? WT_CVW1 : WT_CKW1);
    const bf16_t* w2t = WT + (kv ? WT_CVW2 : WT_CKW2);
    f32x4 acc[16];
#pragma unroll
    for (int i = 0; i < 16; ++i) acc[i] = zero4();
    const int n = n0 + fr;
#pragma unroll 2
    for (int kq = 0; kq < 16; ++kq) {
        const int kk = w * 16 + kq, l = kk >> 1, d = (kk & 1) * 32 + fq * 8;
        int tok = 16 * n + l; tok = tok < S ? tok : S - 1;
        const u32x4 raw = *(const u32x4*)(src + (size_t)tok * LDA + d);
        const float* pp = pos + l * 64 + d;
        const f32x4 p0 = *(const f32x4*)pp, p1 = *(const f32x4*)(pp + 4);
        u32x4 ap;
        ap.x = cvt_pk_bf16(bf_lo(raw.x) + p0[0], bf_hi(raw.x) + p0[1]);
        ap.y = cvt_pk_bf16(bf_lo(raw.y) + p0[2], bf_hi(raw.y) + p0[3]);
        ap.z = cvt_pk_bf16(bf_lo(raw.z) + p1[0], bf_hi(raw.z) + p1[1]);
        ap.w = cvt_pk_bf16(bf_lo(raw.w) + p1[2], bf_hi(raw.w) + p1[3]);
        const bf16x8 a = __builtin_bit_cast(bf16x8, ap);
#pragma unroll
        for (int nt = 0; nt < 16; ++nt) {
            const bf16x8 bw = *(const bf16x8*)(w1t + (size_t)(nt * 16 + fr) * 2048 + kk * 32 + fq * 8);
            acc[nt] = mfma16(bw, a, acc[nt]);
        }
    }
    float* red = (float*)smem;
    bf16_t* hid = (bf16_t*)(smem + 49920);
    if (w > 0) {
#pragma unroll
        for (int nt = 0; nt < 16; ++nt) *(f32x4*)(red + ((w - 1) * 16 + fr) * 260 + nt * 16 + fq * 4) = acc[nt];
    }
    __syncthreads();
    if (w == 0) {
#pragma unroll
        for (int nt = 0; nt < 16; ++nt) {
            f32x4 v = acc[nt];
#pragma unroll
            for (int ww = 0; ww < 3; ++ww) v = v + *(const f32x4*)(red + (ww * 16 + fr) * 260 + nt * 16 + fq * 4);
#pragma unroll
            for (int j = 0; j < 4; ++j) v[j] = gelu_tanh(v[j]);
            *(u32x2*)(hid + fr * 264 + nt * 16 + fq * 4) = pack4(v);
        }
    }
    __syncthreads();
    f32x4 o = zero4();
#pragma unroll
    for (int kk = 0; kk < 8; ++kk) {
        const bf16x8 hf = *(const bf16x8*)(hid + fr * 264 + kk * 32 + fq * 8);
        const bf16x8 wf = *(const bf16x8*)(w2t + (size_t)(w * 16 + fr) * 256 + kk * 32 + fq * 8);
        if (kv == 0) o = mfma16(wf, hf, o);
        else o = mfma16(hf, wf, o);
    }
    if (kv == 0) {
        bf16_t* kc = (bf16_t*)(p.ws + OFF_KC);
        if (w == 0) {
            const float* rope = (const float*)(p.ws + OFF_ROPE);
            int ps = 16 * n + 31; ps = ps < S ? ps : S - 1;
            f32x4 pv;
#pragma unroll
            for (int j = 0; j < 4; ++j) pv[j] = __shfl_xor(o[j], 32);
            const float* rp = rope + ps * 16 + (fq & 1) * 4;
            const f32x4 c = *(const f32x4*)rp, sn = *(const f32x4*)(rp + 8);
            if (fq < 2) o = o * c - pv * sn; else o = o * c + pv * sn;
        }
        if (n >= 255) o = zero4();
        *(u32x2*)(kc + ((size_t)bg * 256 + n) * 64 + w * 16 + fq * 4) = pack4(o);
    } else {
        bf16_t* vct = (bf16_t*)(p.ws + OFF_VCT);
#pragma unroll
        for (int j = 0; j < 4; ++j) if (n0 + fq * 4 + j >= 255) o[j] = 0.f;
        *(u32x2*)(vct + (((size_t)bg * 16 + (n0 >> 4)) * 64 + w * 16 + fr) * 16 + fq * 4) = pack4(o);
    }
    __syncthreads();
}

template <int KW, int VD, bool SEL>
__device__ __forceinline__ void flash_branch(u64 tiles, const bf16_t* __restrict__ gK, int ldk, const bf16_t* __restrict__ gVT, int kcol,
                                             const bf16x8 (&qf)[2][2], f32x4 (&O)[2][VD / 16], float (&mrow)[2], float (&lrow)[2],
                                             const int (&tpos)[2], const u64 (&selm)[2], const int (&lo)[2], int tmin, int lomax, char* smem) {
    constexpr int KROWB = KW * 2, KB = 64 * KROWB, VB = VD * 128, BUFB = KB + VB;
    constexpr int NKI = KB / 4096, NVI = VB / 4096, KRPI = 1024 / KROWB, KCPR = KROWB / 16;
    int tid = threadIdx.x; asm volatile("" : "+v"(tid));
    const int lane = tid & 63, w = tid >> 6, fr = lane & 15, fq = lane >> 4;
    if (!tiles) return;
    int koff[NKI], voff[NVI];
#pragma unroll
    for (int i = 0; i < NKI; ++i) {
        const int row = (w + 4 * i) * KRPI + lane / KCPR, cp = lane % KCPR;
        const int f = (KW == 64) ? (((row >> 1) & 1) | (((row >> 3) & 1) << 1) | (((row >> 4) & 1) << 2)) : ((row & 3) | (((row >> 3) & 3) << 2));
        koff[i] = row * ldk + (cp ^ f) * 8;
    }
#pragma unroll
    for (int i = 0; i < NVI; ++i) {
        const int row = (w + 4 * i) * 8 + (lane >> 3), cp = lane & 7;
        voff[i] = row * S + (cp ^ ((row >> 1) & 7)) * 8;
    }
#define FL_ISSUE(buf, jt) do { char* sb_ = smem + (buf) * BUFB + w * 1024; const bf16_t* gk_ = gK + (size_t)(jt) * 64 * ldk; const bf16_t* gv_ = gVT + (jt) * 64; \
        _Pragma("unroll") for (int i = 0; i < NKI; ++i) __builtin_amdgcn_global_load_lds((const unsigned*)(gk_ + koff[i]), (__attribute__((address_space(3))) unsigned*)(sb_ + i * 4096), 16, 0, 0); \
        _Pragma("unroll") for (int i = 0; i < NVI; ++i) __builtin_amdgcn_global_load_lds((const unsigned*)(gv_ + voff[i]), (__attribute__((address_space(3))) unsigned*)(sb_ + KB + i * 4096), 16, 0, 0); } while (0)
    int j = __ffsll((long long)tiles) - 1; tiles &= tiles - 1;
    FL_ISSUE(0, j);
    asm volatile("s_waitcnt vmcnt(0)" ::: "memory");
    __syncthreads();
    int cur = 0;
    const int kswz = (KW == 64) ? ((fr >> 1) & 7) : fr;
    const int vswz = (fr >> 1) & 7;
    while (true) {
        int jn = -1;
        if (tiles) { jn = __ffsll((long long)tiles) - 1; tiles &= tiles - 1; FL_ISSUE(cur ^ 1, jn); }
        const char* sK = smem + cur * BUFB;
        const char* sV = smem + cur * BUFB + KB;
        f32x4 s[2][4];
        const float mref0 = (mrow[0] < -1e29f) ? 0.f : mrow[0], mref1 = (mrow[1] < -1e29f) ? 0.f : mrow[1];
        const float ci0 = (SEL && !((((const u64*)(smem + 69632))[fr] >> j) & 1ull)) ? -1e30f : -mref0;
        const float ci1 = (SEL && !((((const u64*)(smem + 69632))[16 + fr] >> j) & 1ull)) ? -1e30f : -mref1;
        const f32x4 cinit0 = (f32x4){ci0, ci0, ci0, ci0}, cinit1 = (f32x4){ci1, ci1, ci1, ci1};
#pragma unroll
        for (int tt = 0; tt < 4; ++tt) {
            const int kr = 32 * (tt >> 1) + (fr >> 2) * 8 + (tt & 1) * 4 + (fr & 3);
            const bf16x8 kf0 = *(const bf16x8*)(sK + kr * KROWB + (((kcol >> 3) + fq) ^ kswz) * 16);
            const bf16x8 kf1 = *(const bf16x8*)(sK + kr * KROWB + (((kcol >> 3) + 4 + fq) ^ kswz) * 16);
            s[0][tt] = mfma16(kf0, qf[0][0], cinit0);
            s[1][tt] = mfma16(kf0, qf[1][0], cinit1);
            s[0][tt] = mfma16(kf1, qf[0][1], s[0][tt]);
            s[1][tt] = mfma16(kf1, qf[1][1], s[1][tt]);
        }
        const bool pm = (j * 64 + 63 > tmin) || (j * 64 <= lomax);
        bf16x8 pf[2][2];
#pragma unroll
        for (int qt = 0; qt < 2; ++qt) {
            if (pm) {
                const bool selok = SEL ? (((((const u64*)(smem + 69632))[qt * 16 + fr] >> j) & 1ull) != 0) : true;
                const int t = tpos[qt], lw = lo[qt];
#pragma unroll
                for (int tt = 0; tt < 4; ++tt)
#pragma unroll
                    for (int jj = 0; jj < 4; ++jj) {
                        const int kp = j * 64 + 32 * (tt >> 1) + fq * 8 + (tt & 1) * 4 + jj;
                        const bool ok = selok && (kp <= t) && (kp > lw);
                        s[qt][tt][jj] = ok ? s[qt][tt][jj] : -1e30f;
                    }
            }
            float mx = fmaxf(fmaxf(s[qt][0][0], s[qt][0][1]), fmaxf(s[qt][0][2], s[qt][0][3]));
#pragma unroll
            for (int tt = 1; tt < 4; ++tt) mx = fmaxf(mx, fmaxf(fmaxf(s[qt][tt][0], s[qt][tt][1]), fmaxf(s[qt][tt][2], s[qt][tt][3])));
            const float mref = qt ? mref1 : mref0;
            if (__builtin_amdgcn_ballot_w64(mx > (mrow[qt] - mref) + 8.0f) != 0ull) {
                mx = fmaxf(mx, __shfl_xor(mx, 16));
                mx = fmaxf(mx, __shfl_xor(mx, 32));
                const float mnew = fmaxf(mrow[qt], mx + mref);
                const float alpha = __builtin_amdgcn_exp2f(mrow[qt] - mnew);
                const float delta = ((mnew < -1e29f) ? 0.f : mnew) - mref;
                lrow[qt] *= alpha;
                mrow[qt] = mnew;
#pragma unroll
                for (int dt = 0; dt < VD / 16; ++dt) O[qt][dt] = O[qt][dt] * alpha;
#pragma unroll
                for (int tt = 0; tt < 4; ++tt)
#pragma unroll
                    for (int jj = 0; jj < 4; ++jj) s[qt][tt][jj] -= delta;
            }
            float ps = 0.f;
#pragma unroll
            for (int tt = 0; tt < 4; ++tt)
#pragma unroll
                for (int jj = 0; jj < 4; ++jj) { s[qt][tt][jj] = __builtin_amdgcn_exp2f(s[qt][tt][jj]); ps += s[qt][tt][jj]; }
            lrow[qt] += ps;
#pragma unroll
            for (int i = 0; i < 2; ++i) {
                u32x4 pk;
                pk.x = cvt_pk_bf16(s[qt][2 * i][0], s[qt][2 * i][1]); pk.y = cvt_pk_bf16(s[qt][2 * i][2], s[qt][2 * i][3]);
                pk.z = cvt_pk_bf16(s[qt][2 * i + 1][0], s[qt][2 * i + 1][1]); pk.w = cvt_pk_bf16(s[qt][2 * i + 1][2], s[qt][2 * i + 1][3]);
                pf[qt][i] = __builtin_bit_cast(bf16x8, pk);
            }
        }
#pragma unroll
        for (int i = 0; i < 2; ++i) {
#pragma unroll
            for (int dt = 0; dt < VD / 16; ++dt) {
                const bf16x8 vf = *(const bf16x8*)(sV + (dt * 16 + fr) * 128 + ((i * 4 + fq) ^ vswz) * 16);
                O[0][dt] = mfma16(vf, pf[0][i], O[0][dt]);
                O[1][dt] = mfma16(vf, pf[1][i], O[1][dt]);
            }
        }
        asm volatile("s_waitcnt vmcnt(0)" ::: "memory");
        __syncthreads();
        if (jn < 0) break;
        j = jn; cur ^= 1;
    }
#undef FL_ISSUE
#pragma unroll
    for (int qt = 0; qt < 2; ++qt) { lrow[qt] += __shfl_xor(lrow[qt], 16); lrow[qt] += __shfl_xor(lrow[qt], 32); }
}

__device__ __forceinline__ float sigmoidf_(float x) { return __builtin_amdgcn_rcpf(1.0f + __expf(-x)); }
__device__ __forceinline__ void nsa_tile(const Params& p, int qb, int bg, char* smem) {
    int tid = threadIdx.x; asm volatile("" : "+v"(tid));
    const int lane = tid & 63, w = tid >> 6, fr = lane & 15, fq = lane >> 4;
    const int b = bg >> 2, g = bg & 3, t0 = qb * 32, hq = g * 4 + w;
    const bf16_t* projA = (const bf16_t*)(p.ws + OFF_PROJA);
    const bf16_t* projVT = (const bf16_t*)(p.ws + OFF_PROJVT);
    float* part = (float*)(smem + 36864);
    u64* selmask = (u64*)(smem + 69632);
    bf16x8 qf[2][2];
    int tpos[2];
    float glog[2][3];
#define NSA_GATE(qt, br) sigmoidf_(glog[qt][br])
    const bf16_t* qbase = projA + (size_t)(b * S + t0) * LDA;
#pragma unroll
    for (int qt = 0; qt < 2; ++qt) {
        tpos[qt] = t0 + qt * 16 + fr;
        const bf16_t* qrow = qbase + (size_t)(qt * 16 + fr) * LDA;
#pragma unroll
        for (int ks = 0; ks < 2; ++ks) qf[qt][ks] = *(const bf16x8*)(qrow + hq * 64 + ks * 32 + fq * 8);
#pragma unroll
        for (int br = 0; br < 3; ++br) glog[qt][br] = __uint_as_float(((unsigned)qrow[2048 + hq * 3 + br]) << 16);
    }
    f32x4 outacc[2][4];
    {
        const bf16_t* kcg = (const bf16_t*)(p.ws + OFF_KC) + (size_t)bg * 256 * 64;
        const int nkp0 = (qb >> 4) + 1;
        for (int i = 0; i < nkp0; ++i) {
            const int q = w + 4 * i, row = q * 8 + (lane >> 3), cp = lane & 7;
            const int f = ((row >> 1) & 1) | (((row >> 3) & 1) << 1) | (((row >> 4) & 1) << 2);
            __builtin_amdgcn_global_load_lds((const unsigned*)(kcg + row * 64 + (cp ^ f) * 8), (__attribute__((address_space(3))) unsigned*)(smem + q * 1024), 16, 0, 0);
        }
        asm volatile("s_waitcnt vmcnt(0)" ::: "memory");
    }
    __syncthreads();
    {
        const bf16_t* vct = (const bf16_t*)(p.ws + OFF_VCT) + (size_t)bg * 64 * 256;
        const int nkp = (qb >> 4) + 1;
        float mc[2] = {-1e30f, -1e30f}, lc[2] = {0.f, 0.f};
#pragma unroll 2
        for (int i = 0; i < nkp; ++i) {
#pragma unroll
            for (int half = 0; half < 2; ++half) {
                const int kr = 32 * i + (fr >> 2) * 8 + half * 4 + (fr & 3);
                f32x4 s0 = zero4(), s1 = zero4();
#pragma unroll
                for (int ks = 0; ks < 2; ++ks) {
                    const bf16x8 kf = *(const bf16x8*)(smem + kr * 128 + ((ks * 4 + fq) ^ ((fr >> 1) & 7)) * 16);
                    s0 = mfma16(kf, qf[0][ks], s0);
                    s1 = mfma16(kf, qf[1][ks], s1);
                }
#pragma unroll
                for (int qt = 0; qt < 2; ++qt) {
                    const f32x4 sv = qt ? s1 : s0;
                    float mx = -1e30f; float vals[4];
#pragma unroll
                    for (int jj = 0; jj < 4; ++jj) {
                        const int nn = 32 * i + fq * 8 + half * 4 + jj;
                        vals[jj] = (16 * nn + 31 <= tpos[qt]) ? sv[jj] : -1e30f;
                        mx = fmaxf(mx, vals[jj]);
                    }
                    mx = fmaxf(mx, __shfl_xor(mx, 16));
                    mx = fmaxf(mx, __shfl_xor(mx, 32));
                    const float mnew = fmaxf(mc[qt], mx);
                    float ps = 0.f;
#pragma unroll
                    for (int jj = 0; jj < 4; ++jj) ps += __builtin_amdgcn_exp2f(vals[jj] - mnew);
                    ps += __shfl_xor(ps, 16);
                    ps += __shfl_xor(ps, 32);
                    lc[qt] = lc[qt] * __builtin_amdgcn_exp2f(mc[qt] - mnew) + ps;
                    mc[qt] = mnew;
                }
            }
        }
        const float il[2] = {1.0f / lc[0], 1.0f / lc[1]};
        f32x4 Oc[2][4];
#pragma unroll
        for (int qt = 0; qt < 2; ++qt)
#pragma unroll
            for (int dt = 0; dt < 4; ++dt) Oc[qt][dt] = zero4();
        float carry[2] = {0.f, 0.f};
#pragma unroll 2
        for (int i = 0; i < nkp; ++i) {
            f32x4 pr[2][2];
#pragma unroll
            for (int half = 0; half < 2; ++half) {
                const int kr = 32 * i + (fr >> 2) * 8 + half * 4 + (fr & 3);
                f32x4 s0 = zero4(), s1 = zero4();
#pragma unroll
                for (int ks = 0; ks < 2; ++ks) {
                    const bf16x8 kf = *(const bf16x8*)(smem + kr * 128 + ((ks * 4 + fq) ^ ((fr >> 1) & 7)) * 16);
                    s0 = mfma16(kf, qf[0][ks], s0);
                    s1 = mfma16(kf, qf[1][ks], s1);
                }
#pragma unroll
                for (int qt = 0; qt < 2; ++qt) {
                    const f32x4 sv = qt ? s1 : s0;
#pragma unroll
                    for (int jj = 0; jj < 4; ++jj) {
                        const int nn = 32 * i + fq * 8 + half * 4 + jj;
                        pr[qt][half][jj] = (16 * nn + 31 <= tpos[qt]) ? __builtin_amdgcn_exp2f(sv[jj] - mc[qt]) * il[qt] : 0.f;
                    }
                }
            }
            bf16x8 pfc[2];
#pragma unroll
            for (int qt = 0; qt < 2; ++qt) {
                const float a0 = (pr[qt][0][0] + pr[qt][0][1]) + (pr[qt][0][2] + pr[qt][0][3]);
                const float a1 = (pr[qt][1][0] + pr[qt][1][1]) + (pr[qt][1][2] + pr[qt][1][3]);
                const float e0 = pr[qt][0][3], e1 = pr[qt][1][3];
                const float up = __shfl(e1, (lane + 48) & 63);
                const float c0 = a0 + (fq == 0 ? carry[qt] : up);
                const float c1 = a1 + e0;
                carry[qt] = __shfl(e1, fr + 48);
                float* dst = part + ((w * 32 + qt * 16 + fr) * 64 + 8 * i + 2 * fq);
                *(float2*)dst = make_float2(c0, c1);
                u32x4 pk;
                pk.x = cvt_pk_bf16(pr[qt][0][0], pr[qt][0][1]); pk.y = cvt_pk_bf16(pr[qt][0][2], pr[qt][0][3]);
                pk.z = cvt_pk_bf16(pr[qt][1][0], pr[qt][1][1]); pk.w = cvt_pk_bf16(pr[qt][1][2], pr[qt][1][3]);
                pfc[qt] = __builtin_bit_cast(bf16x8, pk);
            }
#pragma unroll
            for (int dt = 0; dt < 4; ++dt) {
                const bf16x8 vf = *(const bf16x8*)(vct + ((size_t)(2 * i + (fq >> 1)) * 64 + dt * 16 + fr) * 16 + (fq & 1) * 8);
                Oc[0][dt] = mfma16(vf, pfc[0], Oc[0][dt]);
                Oc[1][dt] = mfma16(vf, pfc[1], Oc[1][dt]);
            }
        }
#pragma unroll
        for (int qt = 0; qt < 2; ++qt) {
            const float gq = NSA_GATE(qt, 0);
#pragma unroll
            for (int dt = 0; dt < 4; ++dt) outacc[qt][dt] = Oc[qt][dt] * gq;
        }
    }
    __syncthreads();
    {
        for (int tt = 0; tt < 8; ++tt) {
            const int tok = w * 8 + tt, t = t0 + tok, cur = t >> 6;
            if (cur < 16) {
                if (lane == 0) selmask[tok] = (2ull << cur) - 1ull;
                continue;
            }
            float v = (part[(0 * 32 + tok) * 64 + lane] + part[(1 * 32 + tok) * 64 + lane]) + (part[(2 * 32 + tok) * 64 + lane] + part[(3 * 32 + tok) * 64 + lane]);
            v = (lane < 8 * ((qb >> 4) + 1)) ? v : 0.f;
            const bool forced = (lane == 0) || (lane == cur) || (lane == cur - 1);
            const bool future = lane > cur;
            v = forced ? 1e9f : (future ? -1e9f : v);
            int cnt = 0;
#pragma unroll
            for (int i = 0; i < 64; ++i) {
                const float vi = __uint_as_float(__builtin_amdgcn_readlane(__float_as_uint(v), i));
                cnt += ((vi > v) || (vi == v && i < lane)) ? 1 : 0;
            }
            const u64 mk = __ballot((cnt < 16) && !future);
            if (lane == 0) selmask[tok] = mk;
        }
    }
    __syncthreads();
    u64 ormask = 0;
#pragma unroll 4
    for (int i = 0; i < 32; ++i) ormask |= selmask[i];
    ormask = ((u64)__builtin_amdgcn_readfirstlane((unsigned)(ormask >> 32)) << 32) | (u64)__builtin_amdgcn_readfirstlane((unsigned)ormask);
    const u64 selm[2] = {~0ull, ~0ull};
    const int cur0 = t0 >> 6;
    float* park = part;
    __syncthreads();
#pragma unroll
    for (int qt = 0; qt < 2; ++qt)
#pragma unroll
        for (int dt = 0; dt < 4; ++dt)
            ((f32x4*)park)[(qt * 4 + dt) * 256 + tid] = outacc[qt][dt];
    {
        f32x4 O[2][4];
#pragma unroll
        for (int qt = 0; qt < 2; ++qt)
#pragma unroll
            for (int dt = 0; dt < 4; ++dt) O[qt][dt] = zero4();
        float mr[2] = {-1e30f, -1e30f}, lr[2] = {0.f, 0.f};
        const int lo[2] = {-1, -1};
        flash_branch<64, 64, true>(ormask, projA + (size_t)b * S * LDA + 1536 + g * 64, LDA, projVT + ((size_t)b * 512 + g * 64) * S, 0,
                                   qf, O, mr, lr, tpos, selm, lo, t0, -1, smem);
#pragma unroll
        for (int qt = 0; qt < 2; ++qt) {
            const float sc = NSA_GATE(qt, 1) / lr[qt];
#pragma unroll
            for (int dt = 0; dt < 4; ++dt) ((f32x4*)park)[(qt * 4 + dt) * 256 + tid] = ((f32x4*)park)[(qt * 4 + dt) * 256 + tid] + O[qt][dt] * sc;
        }
    }
    {
        f32x4 O[2][4];
#pragma unroll
        for (int qt = 0; qt < 2; ++qt)
#pragma unroll
            for (int dt = 0; dt < 4; ++dt) O[qt][dt] = zero4();
        float mr[2] = {-1e30f, -1e30f}, lr[2] = {0.f, 0.f};
        const int lo[2] = {tpos[0] - 512, tpos[1] - 512};
        const u64 ones[2] = {~0ull, ~0ull};
        int jlo = t0 - 511; jlo = jlo < 0 ? 0 : (jlo >> 6);
        const u64 upto = (cur0 == 63) ? ~0ull : ((1ull << (cur0 + 1)) - 1ull);
        const u64 tiles = upto & ~((1ull << jlo) - 1ull);
        flash_branch<64, 64, false>(tiles, projA + (size_t)b * S * LDA + 1792 + g * 64, LDA, projVT + ((size_t)b * 512 + 256 + g * 64) * S, 0,
                                    qf, O, mr, lr, tpos, ones, lo, t0, t0 + 31 - 512, smem);
#pragma unroll
        for (int qt = 0; qt < 2; ++qt) {
            const float sc = NSA_GATE(qt, 2) / lr[qt];
            bf16_t* ao = (bf16_t*)(p.ws + OFF_ATTN) + (size_t)(b * S + tpos[qt]) * D + hq * 64 + fq * 4;
#pragma unroll
            for (int dt = 0; dt < 4; ++dt) {
                const f32x4 r = ((f32x4*)park)[(qt * 4 + dt) * 256 + tid] + O[qt][dt] * sc;
                *(u32x2*)(ao + dt * 16) = pack4(r);
            }
        }
    }
    __syncthreads();
}

__device__ __forceinline__ void diff_tile(const Params& p, int qb, int bh, float lam, char* smem) {
    int tid = threadIdx.x; asm volatile("" : "+v"(tid));
    const int lane = tid & 63, w = tid >> 6, fr = lane & 15, fq = lane >> 4;
    const int b = bh >> 3, h = bh & 7, map = w >> 1, half = w & 1, tw0 = qb * 64 + half * 32;
    const bf16_t* projA = (const bf16_t*)(p.ws + OFF_PROJA);
    const bf16_t* projVT = (const bf16_t*)(p.ws + OFF_PROJVT);
    bf16x8 qf[2][2];
    int tpos[2];
#pragma unroll
    for (int qt = 0; qt < 2; ++qt) {
        tpos[qt] = tw0 + qt * 16 + fr;
        const bf16_t* qrow = projA + (size_t)(b * S + tpos[qt]) * LDA + (h * 2 + map) * 64;
#pragma unroll
        for (int ks = 0; ks < 2; ++ks) qf[qt][ks] = *(const bf16x8*)(qrow + ks * 32 + fq * 8);
    }
    f32x4 O[2][8];
#pragma unroll
    for (int qt = 0; qt < 2; ++qt)
#pragma unroll
        for (int dt = 0; dt < 8; ++dt) O[qt][dt] = zero4();
    float mr[2] = {-1e30f, -1e30f}, lr[2] = {0.f, 0.f};
    const int lo[2] = {-1, -1};
    const u64 ones[2] = {~0ull, ~0ull};
    const u64 tiles = (qb == 63) ? ~0ull : ((1ull << (qb + 1)) - 1ull);
    flash_branch<128, 128, false>(tiles, projA + (size_t)b * S * LDA + 1024 + h * 128, LDA, projVT + ((size_t)b * 1024 + h * 128) * S, map * 64,
                                  qf, O, mr, lr, tpos, ones, lo, qb * 64, -1, smem);
    float* xch = (float*)smem;
    const float il[2] = {__builtin_amdgcn_rcpf(lr[0]), __builtin_amdgcn_rcpf(lr[1])};
    if (map == 1) {
#pragma unroll
        for (int qt = 0; qt < 2; ++qt)
#pragma unroll
            for (int dt = 0; dt < 8; ++dt) *(f32x4*)(xch + (half * 32 + qt * 16 + fr) * 132 + dt * 16 + fq * 4) = O[qt][dt] * il[qt];
    }
    __syncthreads();
    if (map == 0) {
        const float* sg = p.in[16];
        bf16_t* ao = (bf16_t*)(p.ws + OFF_ATTN);
#pragma unroll
        for (int qt = 0; qt < 2; ++qt) {
            float ss = 0.f;
#pragma unroll
            for (int dt = 0; dt < 8; ++dt) {
                const f32x4 o2 = *(const f32x4*)(xch + (half * 32 + qt * 16 + fr) * 132 + dt * 16 + fq * 4);
#pragma unroll
                for (int j = 0; j < 4; ++j) {
                    const float o = O[qt][dt][j] * il[qt] - lam * o2[j];
                    O[qt][dt][j] = o; ss += o * o;
                }
            }
            ss += __shfl_xor(ss, 16);
            ss += __shfl_xor(ss, 32);
            const float r = rsqrtf(ss * (1.0f / 128.0f) + EPS) * (1.0f - LAMBDA_INIT);
#pragma unroll
            for (int dt = 0; dt < 8; ++dt) {
                const f32x4 gv = *(const f32x4*)(sg + dt * 16 + fq * 4);
                *(u32x2*)(ao + (size_t)(b * S + tpos[qt]) * D + h * 128 + dt * 16 + fq * 4) = pack4(O[qt][dt] * r * gv);
            }
        }
    }
    __syncthreads();
}

constexpr size_t OFF_BAR = 52 * MiB + 512 * 1024;
#define XB_TMO      128
#define XB_XCNT(j)  (256  + 64 * (j))
#define XB_XSUB(j)  (1280 + 64 * (j))
#define XB_XGEN(j)  (2304 + 64 * (j))
#define XB_TOP      3328
#define XB_TOPGEN   3392
#define XCD_BAR_WORDS 3456
#define XB_SPIN_CAP (1u << 23)
#define LAS __attribute__((address_space(3)))
__device__ __forceinline__ unsigned xb_ld(unsigned* p)              { return __hip_atomic_load(p, __ATOMIC_RELAXED, __HIP_MEMORY_SCOPE_AGENT); }
__device__ __forceinline__ unsigned xb_add(unsigned* p, unsigned v) { return __hip_atomic_fetch_add(p, v, __ATOMIC_RELAXED, __HIP_MEMORY_SCOPE_AGENT); }
__device__ __forceinline__ unsigned xb_xcc_id() { return (unsigned)__builtin_amdgcn_s_getreg((3 << 11) | 20) & 0xFu; }
#define XB_SPIN(cond, bar) do { unsigned _sp = 0; while (cond) { __builtin_amdgcn_s_sleep(1); \
    if ((++_sp & 255u) == 0u) { if (xb_ld(&(bar)[XB_TMO])) break; if (_sp > XB_SPIN_CAP) { atomicAdd(&(bar)[XB_TMO], 1u); break; } } } } while (0)
struct XcdBarrier { unsigned* bar; unsigned x; volatile LAS unsigned* st; };
__device__ __forceinline__ XcdBarrier xcd_barrier_post(unsigned* bar, volatile LAS unsigned* st) {
    XcdBarrier b; b.bar = bar; b.x = xb_xcc_id(); b.st = st;
    if (threadIdx.x == 0) (void)xb_add(&bar[XB_XCNT(b.x)], 1u);
    return b;
}
__device__ __forceinline__ void xcd_barrier_complete(unsigned* bar, unsigned x, unsigned& nloc, unsigned& nx) {
    const unsigned G = gridDim.x * gridDim.y * gridDim.z;
    unsigned sum, cnt, mine, sp = 0u;
    for (;;) {
        sum = 0u; cnt = 0u; mine = 0u;
#pragma unroll
        for (unsigned j = 0; j < 16; ++j) { const unsigned c = xb_ld(&bar[XB_XCNT(j)]); sum += c; cnt += (c > 0u) ? 1u : 0u; mine = (j == x) ? c : mine; }
        if (sum == G) break;
        __builtin_amdgcn_s_sleep(1);
        if ((++sp & 255u) == 0u) { if (xb_ld(&bar[XB_TMO])) break; if (sp > XB_SPIN_CAP) { atomicAdd(&bar[XB_TMO], 1u); break; } }
    }
    nloc = mine > 0u ? mine : 1u; nx = cnt > 0u ? cnt : 1u;
}
__device__ __forceinline__ void gsync(const XcdBarrier& b) {
    asm volatile("s_waitcnt vmcnt(0) lgkmcnt(0)" ::: "memory");
    __syncthreads();
    if (threadIdx.x == 0) {
        unsigned* bar = b.bar; unsigned bx = b.x;
        asm volatile("" : "+s"(bar), "+s"(bx));
        __builtin_amdgcn_s_waitcnt(0);
        unsigned nloc = b.st[0], nx = b.st[1];
        if (nloc == 0u) { xcd_barrier_complete(bar, bx, nloc, nx); b.st[0] = nloc; b.st[1] = nx; }
        const unsigned old = xb_add(&bar[XB_XSUB(bx)], 1u);
        const unsigned gen = old / nloc;
        if (old + 1u == (gen + 1u) * nloc) {
            __builtin_amdgcn_fence(__ATOMIC_RELEASE, "agent");
            asm volatile("s_waitcnt vmcnt(0)" ::: "memory");
            const unsigned og = xb_add(&bar[XB_TOP], 1u);
            const unsigned tg = og / nx;
            if (og + 1u == (tg + 1u) * nx) xb_add(&bar[XB_TOPGEN], 1u);
            else XB_SPIN(xb_ld(&bar[XB_TOPGEN]) == tg, bar);
            __builtin_amdgcn_fence(__ATOMIC_ACQUIRE, "agent");
            xb_add(&bar[XB_XGEN(bx)], 1u);
            asm volatile("s_waitcnt vmcnt(0)" ::: "memory");
        } else {
            XB_SPIN(xb_ld(&bar[XB_XGEN(bx)]) == gen, bar);
            __builtin_amdgcn_fence(__ATOMIC_ACQUIRE, "agent");
            asm volatile("s_waitcnt vmcnt(0)" ::: "memory");
        }
    }
    __syncthreads();
}
__global__ void __launch_bounds__(256, 2) fwd_megakernel(Params p) {
    __shared__ __attribute__((aligned(16))) char smem[SMEM_BYTES];
    __shared__ uint4 xb_words;
    cg::grid_group grid = cg::this_grid();
    if (p.ws == nullptr) grid.sync();
    if (threadIdx.x == 0) xb_words = make_uint4(0u, 0u, 0u, 0u);
    __syncthreads();
    const XcdBarrier xb = xcd_barrier_post((unsigned*)(p.ws + OFF_BAR), (volatile LAS unsigned*)&xb_words);
    bf16_t* WT = (bf16_t*)(p.ws + OFF_WT);
    const float* rope = (const float*)(p.ws + OFF_ROPE);
    bf16_t* xn = (bf16_t*)(p.ws + OFF_XN);
    bf16_t* projA = (bf16_t*)(p.ws + OFF_PROJA);
    bf16_t* projVT = (bf16_t*)(p.ws + OFF_PROJVT);
    bf16_t* attn = (bf16_t*)(p.ws + OFF_ATTN);
    bf16_t* hid = (bf16_t*)(p.ws + OFF_HID);
    const int G = gridDim.x;

    prologue_phase(p, smem);
    rmsnorm_phase(p.in[0], p.in[1], xn, nullptr);
    gsync(xb);
    {
        EpiProj e1{projA, LDA, 1536, rope};
        EpiVT e2{projVT, 512};
        gemm_phase2(xn, WT + WT_NSA_IN, T, 2176, e1, WT + WT_NSA_IN + (size_t)2176 * 1024, xn, 512, T, e2, 1024, smem);
    }
    gsync(xb);
    for (int task = blockIdx.x; task < 1024; task += G) compress_task(p, task, smem);
    gsync(xb);
    for (int r = 0; r * G < 4096; ++r) {
        const int k = (r & 1) ? (G - 1 - (int)blockIdx.x) : (int)blockIdx.x, i = r * G + k;
        if (i < 4096) nsa_tile(p, 127 - (i >> 5), i & 31, smem);
    }
    gsync(xb);
    { EpiResid e{p.in[0], p.out}; gemm_phase(attn, WT + WT_NSA_OUT, T, 1024, 1024, e, smem); }
    gsync(xb);
    rmsnorm_phase(p.out, p.in[2], xn, nullptr);
    gsync(xb);
    { EpiSqRelu e{hid}; gemm_phase(xn, WT + WT_UP0, T, FF, 1024, e, smem); }
    gsync(xb);
    { EpiResid e{p.out, p.out}; gemm_phase(hid, WT + WT_DN0, T, 1024, FF, e, smem); }
    gsync(xb);
    rmsnorm_phase(p.out, p.in[1] + D, xn, nullptr);
    gsync(xb);
    {
        EpiProj e1{projA, LDA, 1024, rope};
        EpiVT e2{projVT, 1024};
        gemm_phase2(xn, WT + WT_DIFF_IN, T, 2048, e1, WT + WT_DIFF_IN + (size_t)2048 * 1024, xn, 1024, T, e2, 1024, smem);
    }
    gsync(xb);
    {
        const int lane = threadIdx.x & 63;
        float a = p.in[12][lane] * p.in[13][lane], c = p.in[14][lane] * p.in[15][lane];
#pragma unroll
        for (int o = 32; o >= 1; o >>= 1) { a += __shfl_xor(a, o); c += __shfl_xor(c, o); }
        const float lam = expf(a) - expf(c) + LAMBDA_INIT;
        for (int r = 0; r * G < 4096; ++r) {
            const int k = (r & 1) ? (G - 1 - (int)blockIdx.x) : (int)blockIdx.x, i = r * G + k;
            if (i < 4096) diff_tile(p, 63 - (i >> 6), i & 63, lam, smem);
        }
    }
    gsync(xb);
    { EpiResid e{p.out, p.out}; gemm_phase(attn, WT + WT_DIFF_OUT, T, 1024, 1024, e, smem); }
    gsync(xb);
    rmsnorm_phase(p.out, p.in[2] + D, xn, nullptr);
    gsync(xb);
    { EpiSqRelu e{hid}; gemm_phase(xn, WT + WT_UP1, T, FF, 1024, e, smem); }
    gsync(xb);
    { EpiResid e{p.out, p.out}; gemm_phase(hid, WT + WT_DN1, T, 1024, FF, e, smem); }
    gsync(xb);
    rmsnorm_phase(p.out, p.in[20], nullptr, p.out);
}

extern "C" void kernel_launch(void* const* d_in, const int* in_sizes, int n_in, void* d_out, int out_size, void* d_ws, size_t ws_size, hipStream_t stream) {
    static int grid_blocks = 0;
    if (!grid_blocks) {
        int dev = 0, cus = 0, per_cu = 0;
        hipGetDevice(&dev);
        hipDeviceGetAttribute(&cus, hipDeviceAttributeMultiprocessorCount, dev);
        hipOccupancyMaxActiveBlocksPerMultiprocessor(&per_cu, fwd_megakernel, 256, 0);
        if (per_cu > 2) per_cu = 2;
        grid_blocks = cus * per_cu;
    }
    if (ws_size < WS_NEED) { fprintf(stderr, "workspace too small: %zu < %zu\n", ws_size, (size_t)WS_NEED); return; }
    Params p{};
    for (int i = 0; i < 21; ++i) p.in[i] = (const float*)d_in[i];
    p.out = (float*)d_out;
    p.ws = (char*)d_ws;
    hipMemsetAsync((char*)d_ws + OFF_BAR, 0, XCD_BAR_WORDS * 4, stream);
    void* args[] = {&p};
    hipError_t e = hipLaunchCooperativeKernel((void*)fwd_megakernel, dim3(grid_blocks), dim3(256), args, 0, stream);
    if (e != hipSuccess) fprintf(stderr, "cooperative launch failed: %s (grid %d)\n", hipGetErrorString(e), grid_blocks);
}
```
